# Optimizing an MI355X kernel written in HIP

```python
import math
import jax, jax.numpy as jnp
from jax import lax
import numpy as np

D_MODEL = 1024
BATCH = 8
SEQ = 2048
DEPTH = 2

CHUNK = 64
Q_BLOCK = 128
N_MIXERS = 2
DIFF_HEADS = 8
DIFF_HEAD_DIM = D_MODEL // (2 * DIFF_HEADS)
SB_HEADS = 16
SB_HEAD_DIM = D_MODEL // SB_HEADS
N_GROUPS = 4
EXPERTS_PER_GROUP = 8
N_EXPERTS = N_GROUPS * EXPERTS_PER_GROUP
TOP_K = 2
EXPERT_HIDDEN = D_MODEL // 2
MOE_BLOCK = 128
RMS_EPS = 1e-6
SUBLN_EPS = 1e-5

kernel_name = "hybrid_diffattn_stickbreak_hmoe_adaln"


def rms_norm(x, g, eps=RMS_EPS):
    xf = x.astype(jnp.float32)
    y = xf * lax.rsqrt(jnp.mean(xf * xf, axis=-1, keepdims=True) + eps)
    return (y * g.astype(jnp.float32)).astype(x.dtype)


def alibi_slopes(n_heads):
    return jnp.exp2(-8.0 * jnp.arange(1, n_heads + 1, dtype=jnp.float32) / n_heads)


def diff_attention(h, w_in, w_out, lq1, lk1, lq2, lk2, subln_g, lambda_init):
    B, S, D = h.shape
    H, d = DIFF_HEADS, DIFF_HEAD_DIM
    q, k, v = jnp.split(h @ w_in, 3, axis=-1)
    q = q.reshape(B, S, H, 2, d)
    k = k.reshape(B, S, H, 2, d)
    v = v.reshape(B, S, H, 2 * d)
    lam = (jnp.exp(jnp.sum(lq1.astype(jnp.float32) * lk1.astype(jnp.float32)))
           - jnp.exp(jnp.sum(lq2.astype(jnp.float32) * lk2.astype(jnp.float32)))
           + lambda_init)
    slopes = alibi_slopes(H)[None, :, None, None, None]
    scale = 1.0 / math.sqrt(d)
    pos = jnp.arange(S, dtype=jnp.int32)
    outs = []
    for i in range(S // Q_BLOCK):
        q0, q1 = i * Q_BLOCK, (i + 1) * Q_BLOCK
        qb, kb, vb = q[:, q0:q1], k[:, :q1], v[:, :q1]
        tq, tk = pos[q0:q1], pos[:q1]
        s = jnp.einsum('bqhmd,bkhmd->bhmqk', qb, kb).astype(jnp.float32) * scale
        dist = jnp.abs(tq[:, None] - tk[None, :]).astype(jnp.float32)
        allowed = (tk[None, :] // CHUNK) <= (tq[:, None] // CHUNK)
        s = jnp.where(allowed, s - slopes * dist, -jnp.inf)
        p = jax.nn.softmax(s, axis=-1)
        a = p[:, :, 0] - lam * p[:, :, 1]
        outs.append(jnp.einsum('bhqk,bkhe->bqhe', a.astype(vb.dtype), vb))
    o = jnp.concatenate(outs, axis=1)
    o = rms_norm(o, subln_g, SUBLN_EPS) * (1.0 - lambda_init)
    return o.reshape(B, S, D) @ w_out


def stick_breaking_attention(h, w_in, w_out):
    B, S, D = h.shape
    H, d = SB_HEADS, SB_HEAD_DIM
    q, k, v = jnp.split(h @ w_in, 3, axis=-1)
    q = q.reshape(B, S, H, d)
    k = k.reshape(B, S, H, d)
    v = v.reshape(B, S, H, d)
    scale = 1.0 / math.sqrt(d)
    pos = jnp.arange(S, dtype=jnp.int32)
    outs = []
    for i in range(S // Q_BLOCK):
        q0, q1 = i * Q_BLOCK, (i + 1) * Q_BLOCK
        qb, kb, vb = q[:, q0:q1], k[:, :q1], v[:, :q1]
        tq, tk = pos[q0:q1], pos[:q1]
        z = jnp.einsum('bqhd,bkhd->bhqk', qb, kb).astype(jnp.float32) * scale
        strict = tk[None, :] < tq[:, None]
        log_fail = jnp.where(strict, jax.nn.log_sigmoid(-z), 0.0)
        between = lax.cumsum(log_fail, axis=log_fail.ndim - 1, reverse=True) - log_fail
        a = jnp.where(strict, jnp.exp(jax.nn.log_sigmoid(z) + between), 0.0)
        outs.append(jnp.einsum('bhqk,bkhd->bqhd', a.astype(vb.dtype), vb))
    o = jnp.concatenate(outs, axis=1)
    return o.reshape(B, S, D) @ w_out


def expert_dispatch(xf, expert_ids, weights, w_gate, w_up, w_down):
    N, D = xf.shape
    NK = expert_ids.shape[0]
    n_slots = NK + N_EXPERTS * MOE_BLOCK
    n_blocks = n_slots // MOE_BLOCK
    token_ids = jnp.arange(NK, dtype=jnp.int32) // TOP_K
    order = jnp.argsort(expert_ids)
    e_sorted = expert_ids[order]
    counts = jnp.zeros((N_EXPERTS,), jnp.int32).at[expert_ids].add(1)
    padded = (counts + MOE_BLOCK - 1) // MOE_BLOCK * MOE_BLOCK
    starts = jnp.cumsum(counts) - counts
    pad_ends = jnp.cumsum(padded)
    pad_starts = pad_ends - padded
    rank = jnp.arange(NK, dtype=jnp.int32) - starts[e_sorted]
    dest = pad_starts[e_sorted] + rank
    slot_tok = jnp.full((n_slots,), N, jnp.int32).at[dest].set(token_ids[order])
    slot_w = jnp.zeros((n_slots,), jnp.float32).at[dest].set(weights[order])
    block_start = jnp.arange(n_blocks, dtype=jnp.int32) * MOE_BLOCK
    block_expert = jnp.minimum(jnp.searchsorted(pad_ends, block_start, side='right'),
                               N_EXPERTS - 1).astype(jnp.int32)
    x_pad = jnp.concatenate([xf, jnp.zeros((1, D), xf.dtype)], axis=0)
    xs = x_pad[slot_tok].reshape(n_blocks, MOE_BLOCK, D)

    def run_block(args):
        xb, e = args
        hid = jax.nn.silu(xb @ w_gate[e]) * (xb @ w_up[e])
        return hid @ w_down[e]

    ys = lax.map(run_block, (xs, block_expert)).reshape(n_slots, D)
    ys = ys * slot_w[:, None].astype(ys.dtype)
    out = jnp.zeros((N + 1, D), ys.dtype).at[slot_tok].add(ys)
    return out[:N]


def hierarchical_moe(h, w_group, b_group, w_expert, b_expert, w_gate, w_up, w_down):
    B, S, D = h.shape
    N = B * S
    xf = h.reshape(N, D)
    rows = jnp.arange(N, dtype=jnp.int32)
    g_logits = (xf @ w_group).astype(jnp.float32) + b_group.astype(jnp.float32)
    g_prob = jax.nn.softmax(g_logits, axis=-1)
    g_idx = jnp.argmax(g_logits, axis=-1).astype(jnp.int32)
    g_w = g_prob[rows, g_idx][:, None]
    e_all = ((xf @ w_expert).astype(jnp.float32).reshape(N, N_GROUPS, EXPERTS_PER_GROUP)
             + b_expert.astype(jnp.float32))
    e_logits = e_all[rows, g_idx]
    top_v, top_i = lax.top_k(e_logits, TOP_K)
    e_w = jax.nn.softmax(top_v, axis=-1)
    weights = (g_w * e_w).reshape(-1)
    expert_ids = (g_idx[:, None] * EXPERTS_PER_GROUP + top_i.astype(jnp.int32)).reshape(-1)
    y = expert_dispatch(xf, expert_ids, weights, w_gate, w_up, w_down)
    return y.reshape(B, S, D)


def setup_inputs(seed: int = 0) -> dict:
    key = jax.random.key(seed)
    ks = jax.random.split(key, 24)
    D, F, E = D_MODEL, EXPERT_HIDDEN, N_EXPERTS
    nA = (DEPTH + 1) // 2
    nB = DEPTH // 2
    dA = DIFF_HEAD_DIM
    nrm = jax.random.normal
    f32 = jnp.float32
    inv = D ** -0.5
    return {
        "x": nrm(ks[0], (BATCH, SEQ, D), f32),
        "c": nrm(ks[1], (BATCH, D), f32),
        "norm1_g": 1.0 + 0.02 * nrm(ks[2], (DEPTH, D), f32),
        "norm2_g": 1.0 + 0.02 * nrm(ks[3], (DEPTH, D), f32),
        "ada_w": 0.5 * inv * nrm(ks[4], (DEPTH, D, 6 * D), f32),
        "ada_b": 0.01 * nrm(ks[5], (DEPTH, 6 * D), f32),
        "diff_w_in": inv * nrm(ks[6], (nA, D, 3 * D), f32),
        "diff_w_out": inv * nrm(ks[7], (nA, D, D), f32),
        "diff_lambda_q1": 0.1 * nrm(ks[8], (nA, dA), f32),
        "diff_lambda_k1": 0.1 * nrm(ks[9], (nA, dA), f32),
        "diff_lambda_q2": 0.1 * nrm(ks[10], (nA, dA), f32),
        "diff_lambda_k2": 0.1 * nrm(ks[11], (nA, dA), f32),
        "diff_subln_g": 1.0 + 0.02 * nrm(ks[12], (nA, 2 * dA), f32),
        "sb_w_in": inv * nrm(ks[13], (nB, D, 3 * D), f32),
        "sb_w_out": inv * nrm(ks[14], (nB, D, D), f32),
        "router_group_w": inv * nrm(ks[15], (DEPTH, D, N_GROUPS), f32),
        "router_group_b": 0.01 * nrm(ks[16], (DEPTH, N_GROUPS), f32),
        "router_expert_w": inv * nrm(ks[17], (DEPTH, D, N_GROUPS * EXPERTS_PER_GROUP), f32),
        "router_expert_b": 0.01 * nrm(ks[18], (DEPTH, N_GROUPS, EXPERTS_PER_GROUP), f32),
        "expert_w_gate": inv * nrm(ks[19], (DEPTH, E, D, F), f32),
        "expert_w_up": inv * nrm(ks[20], (DEPTH, E, D, F), f32),
        "expert_w_down": (F ** -0.5) * nrm(ks[21], (DEPTH, E, F, D), f32),
        "final_norm_g": 1.0 + 0.02 * nrm(ks[22], (D,), f32),
    }


def reference(x, c, norm1_g, norm2_g, ada_w, ada_b, diff_w_in, diff_w_out,
              diff_lambda_q1, diff_lambda_k1, diff_lambda_q2, diff_lambda_k2, diff_subln_g,
              sb_w_in, sb_w_out, router_group_w, router_group_b, router_expert_w,
              router_expert_b, expert_w_gate, expert_w_up, expert_w_down, final_norm_g):
    cond = jax.nn.silu(c)
    for i in range(DEPTH):
        mod = cond @ ada_w[i] + ada_b[i]
        sh1, sc1, g1, sh2, sc2, g2 = jnp.split(mod[:, None, :], 6, axis=-1)
        h = rms_norm(x, norm1_g[i]) * (1.0 + sc1) + sh1
        j = i // N_MIXERS
        if i % N_MIXERS == 0:
            lambda_init = 0.8 - 0.6 * math.exp(-0.3 * i)
            y = diff_attention(h, diff_w_in[j], diff_w_out[j], diff_lambda_q1[j],
                               diff_lambda_k1[j], diff_lambda_q2[j], diff_lambda_k2[j],
                               diff_subln_g[j], lambda_init)
        else:
            y = stick_breaking_attention(h, sb_w_in[j], sb_w_out[j])
        x = x + g1 * y
        h = rms_norm(x, norm2_g[i]) * (1.0 + sc2) + sh2
        y = hierarchical_moe(h, router_group_w[i], router_group_b[i], router_expert_w[i],
                             router_expert_b[i], expert_w_gate[i], expert_w_up[i],
                             expert_w_down[i])
        x = x + g2 * y
    return rms_norm(x, final_norm_g)
```

```cpp
#include <hip/hip_runtime.h>
#include <cstdio>
#include <cstdint>
#include <cmath>

namespace {
constexpr int D = 1024, BATCH = 8, SEQ = 2048, NTOK = BATCH * SEQ, DEPTH = 2;
constexpr int NG = 4, EPG = 8, NE = 32, TOPK = 2, FH = 512;
constexpr int NPAIR = NTOK * TOPK;
constexpr int SLOT_PAD = 64;
constexpr int MAX_SLOTS = NPAIR + NE * SLOT_PAD;
constexpr int MAX_TILES = MAX_SLOTS / SLOT_PAD;

__device__ __forceinline__ float wave_sum(float v) {
#pragma unroll
    for (int o = 1; o < 64; o <<= 1) v += __shfl_xor(v, o);
    return v;
}
__device__ __forceinline__ float wave_max(float v) {
#pragma unroll
    for (int o = 1; o < 64; o <<= 1) v = fmaxf(v, __shfl_xor(v, o));
    return v;
}

__global__ void __launch_bounds__(256) k_mod(const float* __restrict__ c, const float* __restrict__ ada_w, const float* __restrict__ ada_b, float* __restrict__ mod) {
    __shared__ float cond[BATCH][D];
    __shared__ float red[4][BATCH][64];
    const int l = blockIdx.y, j0 = blockIdx.x * 64, tid = threadIdx.x;
    for (int i = tid; i < BATCH * D; i += 256) { float v = c[i]; cond[i / D][i % D] = v / (1.f + expf(-v)); }
    __syncthreads();
    const int kq = tid >> 6, jj = tid & 63;
    float acc[BATCH];
#pragma unroll
    for (int b = 0; b < BATCH; ++b) acc[b] = 0.f;
    const float* W = ada_w + (size_t)l * D * 6 * D + j0 + jj;
    for (int k = kq * 256; k < kq * 256 + 256; ++k) {
        const float w = W[(size_t)k * 6 * D];
#pragma unroll
        for (int b = 0; b < BATCH; ++b) acc[b] += cond[b][k] * w;
    }
#pragma unroll
    for (int b = 0; b < BATCH; ++b) red[kq][b][jj] = acc[b];
    __syncthreads();
    for (int i = tid; i < BATCH * 64; i += 256) {
        const int b = i >> 6, j = i & 63;
        mod[((size_t)l * BATCH + b) * 6 * D + j0 + j] = red[0][b][j] + red[1][b][j] + red[2][b][j] + red[3][b][j] + ada_b[(size_t)l * 6 * D + j0 + j];
    }
}

__global__ void __launch_bounds__(256) k_norm(const float* __restrict__ x, const float* __restrict__ g, const float* __restrict__ sh, const float* __restrict__ sc, float* __restrict__ out, float eps) {
    const int row = blockIdx.x * 4 + (threadIdx.x >> 6), lane = threadIdx.x & 63;
    const int b = row / SEQ;
    const float4* xr = (const float4*)(x + (size_t)row * D);
    float4 v[4]; float ss = 0.f;
#pragma unroll
    for (int j = 0; j < 4; ++j) { v[j] = xr[lane + 64 * j]; ss += v[j].x * v[j].x + v[j].y * v[j].y + v[j].z * v[j].z + v[j].w * v[j].w; }
    ss = wave_sum(ss);
    const float r = 1.0f / sqrtf(ss * (1.f / D) + eps);
    float4* o = (float4*)(out + (size_t)row * D);
#pragma unroll
    for (int j = 0; j < 4; ++j) {
        const int c0 = (lane + 64 * j) * 4;
        const float4 gg = *(const float4*)(g + c0);
        float4 y; y.x = v[j].x * r * gg.x; y.y = v[j].y * r * gg.y; y.z = v[j].z * r * gg.z; y.w = v[j].w * r * gg.w;
        if (sc) {
            const float4 s1 = *(const float4*)(sc + (size_t)b * 6 * D + c0), s0 = *(const float4*)(sh + (size_t)b * 6 * D + c0);
            y.x = y.x * (1.f + s1.x) + s0.x; y.y = y.y * (1.f + s1.y) + s0.y; y.z = y.z * (1.f + s1.z) + s0.z; y.w = y.w * (1.f + s1.w) + s0.w;
        }
        o[lane + 64 * j] = y;
    }
}

struct GemmArgs {
    const float* A; int lda; const int* rowidx;
    const float* B; int ldb; const int* tile_expert; size_t b_expert_stride;
    float* C; int ldc; int K; const int* ntiles;
    const float* X; const float* gate;
};
template <int MODE>
__global__ void __launch_bounds__(256) k_gemm(GemmArgs g) {
    __shared__ float As[16][68];
    __shared__ float Bs[16][64];
    const int tm = blockIdx.y, tn = blockIdx.x, tid = threadIdx.x;
    if (g.ntiles && tm >= *g.ntiles) return;
    const float* B = g.B + (g.tile_expert ? (size_t)g.tile_expert[tm] * g.b_expert_stride : 0) + tn * 64;
    const int ar = tid >> 2, akq = (tid & 3) * 4;
    int arow = tm * 64 + ar; if (g.rowidx) arow = g.rowidx[arow];
    const float* Ap = g.A + (size_t)(arow < 0 ? 0 : arow) * g.lda + akq;
    const int bk = tid >> 4, bn = (tid & 15) * 4;
    const int ty = tid >> 4, tx = tid & 15;
    float acc[4][4];
#pragma unroll
    for (int i = 0; i < 4; ++i)
#pragma unroll
        for (int j = 0; j < 4; ++j) acc[i][j] = 0.f;
    for (int k0 = 0; k0 < g.K; k0 += 16) {
        float4 a = (arow < 0) ? make_float4(0.f, 0.f, 0.f, 0.f) : *(const float4*)(Ap + k0);
        float4 b = *(const float4*)(B + (size_t)(k0 + bk) * g.ldb + bn);
        As[akq + 0][ar] = a.x; As[akq + 1][ar] = a.y; As[akq + 2][ar] = a.z; As[akq + 3][ar] = a.w;
        *(float4*)&Bs[bk][bn] = b;
        __syncthreads();
#pragma unroll
        for (int k = 0; k < 16; ++k) {
            const float4 av = *(const float4*)&As[k][ty * 4];
            const float4 bv = *(const float4*)&Bs[k][tx * 4];
            const float aa[4] = {av.x, av.y, av.z, av.w}, bb[4] = {bv.x, bv.y, bv.z, bv.w};
#pragma unroll
            for (int i = 0; i < 4; ++i)
#pragma unroll
                for (int j = 0; j < 4; ++j) acc[i][j] += aa[i] * bb[j];
        }
        __syncthreads();
    }
#pragma unroll
    for (int i = 0; i < 4; ++i) {
        const int r = tm * 64 + ty * 4 + i, c = tn * 64 + tx * 4;
        float4 o = make_float4(acc[i][0], acc[i][1], acc[i][2], acc[i][3]);
        if (MODE == 1) {
            const int b = r / SEQ;
            const float4 xv = *(const float4*)(g.X + (size_t)r * g.ldc + c), gv = *(const float4*)(g.gate + (size_t)b * 6 * D + c);
            o.x = xv.x + gv.x * o.x; o.y = xv.y + gv.y * o.y; o.z = xv.z + gv.z * o.z; o.w = xv.w + gv.w * o.w;
        }
        *(float4*)(g.C + (size_t)r * g.ldc + c) = o;
    }
}

__global__ void __launch_bounds__(128) k_attn_diff(const float* __restrict__ qkv, const float* __restrict__ lq1, const float* __restrict__ lk1, const float* __restrict__ lq2, const float* __restrict__ lk2,
                                                    const float* __restrict__ subg, float lambda_init, float* __restrict__ O) {
    __shared__ float sq[2][128];
    __shared__ float s1[2][SEQ];
    __shared__ float s2[2][SEQ];
    const int w = threadIdx.x >> 6, lane = threadIdx.x & 63;
    const int bh = blockIdx.y, b = bh / 8, h = bh % 8, tq = blockIdx.x * 2 + w;
    const float* base = qkv + (size_t)b * SEQ * 3 * D;
    const float* qp = base + (size_t)tq * 3 * D + h * 128;
    sq[w][lane] = qp[lane]; sq[w][64 + lane] = qp[64 + lane];
    float l1 = lq1[lane] * lk1[lane], l2 = lq2[lane] * lk2[lane];
    l1 = wave_sum(l1); l2 = wave_sum(l2);
    const float lam = expf(l1) - expf(l2) + lambda_init;
    const float slope = exp2f(-8.0f * (float)(h + 1) / 8.0f);
    __syncthreads();
    const int nk = (tq / 64 + 1) * 64;
    float m1 = -INFINITY, m2 = -INFINITY;
    for (int s = lane; s < nk; s += 64) {
        const float* kp = base + (size_t)s * 3 * D + D + h * 128;
        float d1 = 0.f, d2 = 0.f;
        for (int d = 0; d < 64; d += 4) {
            const float4 k1 = *(const float4*)(kp + d), k2 = *(const float4*)(kp + 64 + d);
            d1 += sq[w][d] * k1.x + sq[w][d + 1] * k1.y + sq[w][d + 2] * k1.z + sq[w][d + 3] * k1.w;
            d2 += sq[w][64 + d] * k2.x + sq[w][64 + d + 1] * k2.y + sq[w][64 + d + 2] * k2.z + sq[w][64 + d + 3] * k2.w;
        }
        const float dist = fabsf((float)(tq - s));
        const float a1 = d1 * 0.125f - slope * dist, a2 = d2 * 0.125f - slope * dist;
        s1[w][s] = a1; s2[w][s] = a2; m1 = fmaxf(m1, a1); m2 = fmaxf(m2, a2);
    }
    m1 = wave_max(m1); m2 = wave_max(m2);
    float z1 = 0.f, z2 = 0.f;
    for (int s = lane; s < nk; s += 64) { const float e1 = expf(s1[w][s] - m1), e2 = expf(s2[w][s] - m2); s1[w][s] = e1; s2[w][s] = e2; z1 += e1; z2 += e2; }
    z1 = wave_sum(z1); z2 = wave_sum(z2);
    const float r1 = 1.f / z1, r2 = lam / z2;
    for (int s = lane; s < nk; s += 64) s1[w][s] = s1[w][s] * r1 - s2[w][s] * r2;
    __syncthreads();
    float o0 = 0.f, o1 = 0.f;
    const float* vp = base + 2 * D + h * 128 + lane;
    for (int s = 0; s < nk; ++s) { const float a = s1[w][s]; o0 += a * vp[(size_t)s * 3 * D]; o1 += a * vp[(size_t)s * 3 * D + 64]; }
    const float ss = wave_sum(o0 * o0 + o1 * o1) * (1.f / 128.f);
    const float r = 1.0f / sqrtf(ss + 1e-5f) * (1.0f - lambda_init);
    float* op = O + ((size_t)b * SEQ + tq) * D + h * 128;
    op[lane] = o0 * r * subg[lane]; op[64 + lane] = o1 * r * subg[64 + lane];
}

__global__ void __launch_bounds__(256) k_attn_sb(const float* __restrict__ qkv, float* __restrict__ O) {
    __shared__ float sq[4][64];
    __shared__ float zz[4][SEQ];
    const int w = threadIdx.x >> 6, lane = threadIdx.x & 63;
    const int bh = blockIdx.y, b = bh / 16, h = bh % 16, t = blockIdx.x * 4 + w;
    const float* base = qkv + (size_t)b * SEQ * 3 * D;
    sq[w][lane] = base[(size_t)t * 3 * D + h * 64 + lane];
    __syncthreads();
    const int s0 = lane * 32;
    float seg = 0.f;
    for (int i = 0; i < 32; ++i) {
        const int s = s0 + i;
        if (s < t) {
            const float* kp = base + (size_t)s * 3 * D + D + h * 64;
            float d = 0.f;
            for (int dd = 0; dd < 64; dd += 4) { const float4 k = *(const float4*)(kp + dd); d += sq[w][dd] * k.x + sq[w][dd + 1] * k.y + sq[w][dd + 2] * k.z + sq[w][dd + 3] * k.w; }
            const float z = d * 0.125f;
            zz[w][s] = z;
            seg += -(fmaxf(z, 0.f) + log1pf(expf(-fabsf(z))));
        }
    }
    float incl = seg;
#pragma unroll
    for (int o = 1; o < 64; o <<= 1) { const float v = __shfl_down(incl, o); if (lane + o < 64) incl += v; }
    float run = incl - seg;
    for (int i = 31; i >= 0; --i) {
        const int s = s0 + i;
        if (s < t) {
            const float z = zz[w][s];
            const float lf = -(fmaxf(z, 0.f) + log1pf(expf(-fabsf(z))));
            zz[w][s] = expf(z + lf + run);
            run += lf;
        }
    }
    __syncthreads();
    float o = 0.f;
    const float* vp = base + 2 * D + h * 64 + lane;
    for (int s = 0; s < t; ++s) o += zz[w][s] * vp[(size_t)s * 3 * D];
    O[((size_t)b * SEQ + t) * D + h * 64 + lane] = o;
}

__global__ void __launch_bounds__(256) k_router(const float* __restrict__ hn, const float* __restrict__ wg, const float* __restrict__ bg, const float* __restrict__ we, const float* __restrict__ be,
                                                 int* __restrict__ eid, float* __restrict__ ew) {
    const int row = blockIdx.x * 4 + (threadIdx.x >> 6), lane = threadIdx.x & 63;
    float acc[36];
#pragma unroll
    for (int j = 0; j < 36; ++j) acc[j] = 0.f;
    for (int i = 0; i < 16; ++i) {
        const int k = lane + 64 * i;
        const float hv = hn[(size_t)row * D + k];
        const float4 g4 = *(const float4*)(wg + (size_t)k * 4);
        acc[0] += hv * g4.x; acc[1] += hv * g4.y; acc[2] += hv * g4.z; acc[3] += hv * g4.w;
#pragma unroll
        for (int j = 0; j < 8; ++j) { const float4 e4 = *(const float4*)(we + (size_t)k * 32 + 4 * j); acc[4 + 4 * j] += hv * e4.x; acc[5 + 4 * j] += hv * e4.y; acc[6 + 4 * j] += hv * e4.z; acc[7 + 4 * j] += hv * e4.w; }
    }
#pragma unroll
    for (int j = 0; j < 36; ++j) acc[j] = wave_sum(acc[j]);
    if (lane == 0) {
        float gl[4]; int gi = 0; float gm = -INFINITY;
#pragma unroll
        for (int j = 0; j < 4; ++j) { gl[j] = acc[j] + bg[j]; if (gl[j] > gm) { gm = gl[j]; gi = j; } }
        float gs = 0.f;
#pragma unroll
        for (int j = 0; j < 4; ++j) gs += expf(gl[j] - gm);
        const float gw = 1.0f / gs;
        float v1 = -INFINITY, v2 = -INFINITY; int i1 = 0, i2 = 0;
#pragma unroll
        for (int g = 0; g < 4; ++g) {
            if (g == gi) {
#pragma unroll
                for (int j = 0; j < 8; ++j) {
                    const float v = acc[4 + g * 8 + j] + be[g * 8 + j];
                    if (v > v1) { v2 = v1; i2 = i1; v1 = v; i1 = j; } else if (v > v2) { v2 = v; i2 = j; }
                }
            }
        }
        const float e2 = expf(v2 - v1), den = 1.f + e2;
        eid[row * 2] = gi * 8 + i1; eid[row * 2 + 1] = gi * 8 + i2;
        ew[row * 2] = gw / den; ew[row * 2 + 1] = gw * e2 / den;
    }
}

__global__ void k_count(const int* __restrict__ eid, int* __restrict__ ctl, int* __restrict__ rank) {
    const int p = blockIdx.x * blockDim.x + threadIdx.x;
    if (p < NPAIR) rank[p] = atomicAdd(&ctl[eid[p]], 1);
}
__global__ void k_plan(int* __restrict__ ctl) {
    if (threadIdx.x == 0) {
        int off = 0;
        for (int e = 0; e < NE; ++e) {
            ctl[32 + e] = off;
            const int nt = (ctl[e] + SLOT_PAD - 1) / SLOT_PAD;
            for (int t = 0; t < nt; ++t) ctl[128 + off / SLOT_PAD + t] = e;
            off += nt * SLOT_PAD;
        }
        ctl[64] = off / SLOT_PAD;
    }
}
__global__ void k_assign(const int* __restrict__ eid, const int* __restrict__ ctl, const int* __restrict__ rank, int* __restrict__ slot_tok, int* __restrict__ slot_of_pair) {
    const int p = blockIdx.x * blockDim.x + threadIdx.x;
    if (p < NPAIR) { const int s = ctl[32 + eid[p]] + rank[p]; slot_tok[s] = p >> 1; slot_of_pair[p] = s; }
}
__global__ void k_swiglu(const float* __restrict__ G, const float* __restrict__ U, float* __restrict__ H, const int* __restrict__ ctl) {
    const size_t n = (size_t)ctl[64] * SLOT_PAD * FH;
    for (size_t i = (size_t)blockIdx.x * blockDim.x + threadIdx.x; i < n; i += (size_t)gridDim.x * blockDim.x) { const float g = G[i]; H[i] = g / (1.f + expf(-g)) * U[i]; }
}
__global__ void __launch_bounds__(256) k_combine(float* __restrict__ xs, const float* __restrict__ Yd, const int* __restrict__ slot_of_pair, const float* __restrict__ ew, const float* __restrict__ gate) {
    const int row = blockIdx.x, b = row / SEQ, c = threadIdx.x * 4;
    const int s0 = slot_of_pair[row * 2], s1 = slot_of_pair[row * 2 + 1];
    const float w0 = ew[row * 2], w1 = ew[row * 2 + 1];
    const float4 y0 = *(const float4*)(Yd + (size_t)s0 * D + c), y1 = *(const float4*)(Yd + (size_t)s1 * D + c), g = *(const float4*)(gate + (size_t)b * 6 * D + c);
    float4 x = *(float4*)(xs + (size_t)row * D + c);
    x.x += g.x * (w0 * y0.x + w1 * y1.x); x.y += g.y * (w0 * y0.y + w1 * y1.y); x.z += g.z * (w0 * y0.z + w1 * y1.z); x.w += g.w * (w0 * y0.w + w1 * y1.w);
    *(float4*)(xs + (size_t)row * D + c) = x;
}
}

extern "C" void kernel_launch(void* const* d_in, const int* in_sizes, int n_in, void* d_out, int out_size, void* d_ws, size_t ws_size, hipStream_t stream) {
    const float* x = (const float*)d_in[0]; const float* c = (const float*)d_in[1];
    const float* norm1_g = (const float*)d_in[2]; const float* norm2_g = (const float*)d_in[3];
    const float* ada_w = (const float*)d_in[4]; const float* ada_b = (const float*)d_in[5];
    const float* diff_w_in = (const float*)d_in[6]; const float* diff_w_out = (const float*)d_in[7];
    const float* lq1 = (const float*)d_in[8]; const float* lk1 = (const float*)d_in[9]; const float* lq2 = (const float*)d_in[10]; const float* lk2 = (const float*)d_in[11];
    const float* subg = (const float*)d_in[12];
    const float* sb_w_in = (const float*)d_in[13]; const float* sb_w_out = (const float*)d_in[14];
    const float* rgw = (const float*)d_in[15]; const float* rgb = (const float*)d_in[16]; const float* rew = (const float*)d_in[17]; const float* reb = (const float*)d_in[18];
    const float* wgate = (const float*)d_in[19]; const float* wup = (const float*)d_in[20]; const float* wdown = (const float*)d_in[21];
    const float* final_g = (const float*)d_in[22];
    float* xs = (float*)d_out;
    char* ws = (char*)d_ws;
    constexpr size_t MiB = 1u << 20;
    int* ctl = (int*)ws;
    float* mod = (float*)(ws + 1 * MiB);
    int* eid = (int*)(ws + 2 * MiB); float* ew = (float*)(ws + 3 * MiB);
    int* rank = (int*)(ws + 4 * MiB); int* slot_tok = (int*)(ws + 5 * MiB); int* slot_of_pair = (int*)(ws + 6 * MiB);
    float* hn = (float*)(ws + 8 * MiB);
    float* o = (float*)(ws + 72 * MiB);
    float* qkv = (float*)(ws + 136 * MiB);
    float* G = qkv;
    float* U = (float*)(ws + 206 * MiB);
    float* Hm = hn == nullptr ? nullptr : (float*)(ws + 72 * MiB);
    float* Yd = (float*)(ws + 276 * MiB);
    Hm = (float*)(ws + 412 * MiB);
    (void)in_sizes; (void)n_in; (void)out_size; (void)ws_size;

    k_mod<<<dim3(96, 2), 256, 0, stream>>>(c, ada_w, ada_b, mod);
    for (int l = 0; l < DEPTH; ++l) {
        const float* m = mod + (size_t)l * BATCH * 6 * D;
        const float* xin = (l == 0) ? x : xs;
        k_norm<<<NTOK / 4, 256, 0, stream>>>(xin, norm1_g + l * D, m, m + D, hn, 1e-6f);
        GemmArgs g{};
        g.A = hn; g.lda = D; g.B = (l == 0) ? diff_w_in : sb_w_in; g.ldb = 3 * D; g.C = qkv; g.ldc = 3 * D; g.K = D;
        k_gemm<0><<<dim3(3 * D / 64, NTOK / 64), 256, 0, stream>>>(g);
        if (l == 0) k_attn_diff<<<dim3(SEQ / 2, BATCH * 8), 128, 0, stream>>>(qkv, lq1, lk1, lq2, lk2, subg, 0.2f, o);
        else k_attn_sb<<<dim3(SEQ / 4, BATCH * 16), 256, 0, stream>>>(qkv, o);
        GemmArgs g2{};
        g2.A = o; g2.lda = D; g2.B = (l == 0) ? diff_w_out : sb_w_out; g2.ldb = D; g2.C = xs; g2.ldc = D; g2.K = D; g2.X = xin; g2.gate = m + 2 * D;
        k_gemm<1><<<dim3(D / 64, NTOK / 64), 256, 0, stream>>>(g2);
        k_norm<<<NTOK / 4, 256, 0, stream>>>(xs, norm2_g + l * D, m + 3 * D, m + 4 * D, hn, 1e-6f);
        k_router<<<NTOK / 4, 256, 0, stream>>>(hn, rgw + (size_t)l * D * NG, rgb + l * NG, rew + (size_t)l * D * NE, reb + l * NE, eid, ew);
        hipMemsetAsync(ctl, 0, 16384, stream);
        hipMemsetAsync(slot_tok, 0xFF, MAX_SLOTS * sizeof(int), stream);
        k_count<<<NPAIR / 256, 256, 0, stream>>>(eid, ctl, rank);
        k_plan<<<1, 64, 0, stream>>>(ctl);
        k_assign<<<NPAIR / 256, 256, 0, stream>>>(eid, ctl, rank, slot_tok, slot_of_pair);
        GemmArgs ga{};
        ga.A = hn; ga.lda = D; ga.rowidx = slot_tok; ga.B = wgate + (size_t)l * NE * D * FH; ga.ldb = FH; ga.tile_expert = ctl + 128; ga.b_expert_stride = (size_t)D * FH;
        ga.C = G; ga.ldc = FH; ga.K = D; ga.ntiles = ctl + 64;
        k_gemm<0><<<dim3(FH / 64, MAX_TILES), 256, 0, stream>>>(ga);
        ga.B = wup + (size_t)l * NE * D * FH; ga.C = U;
        k_gemm<0><<<dim3(FH / 64, MAX_TILES), 256, 0, stream>>>(ga);
        k_swiglu<<<2048, 256, 0, stream>>>(G, U, Hm, ctl);
        GemmArgs gd{};
        gd.A = Hm; gd.lda = FH; gd.B = wdown + (size_t)l * NE * FH * D; gd.ldb = D; gd.tile_expert = ctl + 128; gd.b_expert_stride = (size_t)FH * D;
        gd.C = Yd; gd.ldc = D; gd.K = FH; gd.ntiles = ctl + 64;
        k_gemm<0><<<dim3(D / 64, MAX_TILES), 256, 0, stream>>>(gd);
        k_combine<<<NTOK, 256, 0, stream>>>(xs, Yd, slot_of_pair, ew, m + 5 * D);
    }
    k_norm<<<NTOK / 4, 256, 0, stream>>>(xs, final_g, nullptr, nullptr, xs, 1e-6f);
}
```

```cpp
#include <hip/hip_runtime.h>
#include <cstdio>
#include <cstdint>
#include <cmath>

#ifndef MK_ONE_LAUNCH
#define MK_ONE_LAUNCH 1
#endif

namespace pg8 {
#define PG8_LAS __attribute__((address_space(3)))
typedef unsigned short bf16_t;
typedef short bf16x8 __attribute__((ext_vector_type(8)));
typedef float f32x4 __attribute__((ext_vector_type(4)));
typedef unsigned u32x4 __attribute__((ext_vector_type(4)));
constexpr int BM = 256, BK = 64, HALF = 128, HTB = HALF * BK * 2, NXCD = 8, WGM = 8;

__host__ __device__ __forceinline__ int lds_byte(int r, int c) { const int st = (r >> 4) * 2 + (c >> 5), rr = r & 15, cc = c & 31, ob = rr * 64 + cc * 2; return st * 1024 + (ob ^ (((ob >> 9) & 1) << 5)); }
__host__ __device__ __forceinline__ void stage_rc(int b, int& R, int& C) { const int st = b / 1024, sb = b % 1024, swz = sb ^ (((sb >> 9) & 1) << 5); R = (st >> 1) * 16 + swz / 64; C = (st & 1) * 32 + (swz % 64) / 2; }
__host__ __device__ __forceinline__ int perm32(int rho) { const int n = rho >> 4, i = rho & 15; return 8 * (i >> 2) + 4 * n + (i & 3); }

struct Unit { int pm, pn; const bf16_t* Bt; };

struct StaticOrder {
    int nM, nN, nwg, G, c; const bf16_t* Bt;
    __device__ void init(int M, int N, int G_, int c_, const bf16_t* Bt_) { nM = M / BM; nN = N / BM; nwg = nM * nN; G = G_; c = c_; Bt = Bt_; }
    __device__ bool next(int i, Unit& u) const {
        const long L = (long)i * G + c; if (L >= nwg) return false;
        int wgid = (int)L; { const int q = nwg / NXCD, r = nwg % NXCD, xcd = wgid % NXCD, off = wgid / NXCD; wgid = (xcd < r ? xcd * (q + 1) : r * (q + 1) + (xcd - r) * q) + off; }
        const int nig = WGM * nN, gid = wgid / nig, fm = gid * WGM, gsz = (nM - fm) < WGM ? (nM - fm) : WGM;
        u.pm = fm + ((wgid % nig) % gsz); u.pn = (wgid % nig) / gsz; u.Bt = Bt; return true;
    }
};
struct GroupedOrder {
    const PG8_LAS int* tl; int G, c; const bf16_t* Bt; size_t estride;
    __device__ bool next(int i, Unit& u) const {
        const int L = i * G + c; const int nt = tl[0]; if (L >= nt * 4) return false;
        u.pm = L >> 2; u.pn = L & 3; u.Bt = Bt + (size_t)tl[1 + (L >> 2)] * estride; return true;
    }
};

__device__ __forceinline__ unsigned cvt_pk_bf16(float lo, float hi) { unsigned r; asm volatile("v_cvt_pk_bf16_f32 %0, %1, %2" : "=v"(r) : "v"(lo), "v"(hi)); return r; }

struct EpiBf16 {
    static constexpr bool PERM = true;
    bf16_t* O; int ldc; int split_cols; size_t split_stride; float scale0;
    __device__ __forceinline__ void operator()(const f32x4 (&acc)[2][2][4][2], const Unit& u, int wr, int wc, int fr, int fq) const {
        const int row0 = u.pm * BM + wr * 64 + fr; int colt = u.pn * BM; bf16_t* base = O;
        float sc = 1.f; if (split_cols) { const int t = colt / split_cols; base += (size_t)t * split_stride; colt -= t * split_cols; if (t == 0) sc = scale0; }
        const int col0 = colt + wc * 32 + 8 * fq;
#pragma unroll
        for (int ai = 0; ai < 2; ++ai)
#pragma unroll
            for (int m = 0; m < 4; ++m) { bf16_t* rowp = base + (size_t)(row0 + ai * HALF + m * 16) * ldc + col0;
#pragma unroll
                for (int bj = 0; bj < 2; ++bj) { const f32x4 v0 = acc[ai][bj][m][0] * sc, v1 = acc[ai][bj][m][1] * sc;
                    u32x4 w; w.x = cvt_pk_bf16(v0[0], v0[1]); w.y = cvt_pk_bf16(v0[2], v0[3]); w.z = cvt_pk_bf16(v1[0], v1[1]); w.w = cvt_pk_bf16(v1[2], v1[3]);
                    *(u32x4*)(rowp + bj * HALF) = w; } }
    }
};
struct EpiResid {
    static constexpr bool PERM = false;
    float* C; const float* X; int ldc; const float* gate; int gstride; int rows_per_batch;
    __device__ __forceinline__ void operator()(const f32x4 (&acc)[2][2][4][2], const Unit& u, int wr, int wc, int fr, int fq) const {
        const int row0 = u.pm * BM + wr * 64 + fr, col0 = u.pn * BM + wc * 32 + 4 * fq;
        const float* gp = gate + (size_t)((u.pm * BM) / rows_per_batch) * gstride + col0;
        f32x4 gv[2][2];
#pragma unroll
        for (int bj = 0; bj < 2; ++bj)
#pragma unroll
            for (int n = 0; n < 2; ++n) gv[bj][n] = *(const f32x4*)(gp + bj * HALF + n * 16);
#pragma unroll
        for (int ai = 0; ai < 2; ++ai)
#pragma unroll
            for (int m = 0; m < 4; ++m) { const size_t ro = (size_t)(row0 + ai * HALF + m * 16) * ldc + col0;
#pragma unroll
                for (int bj = 0; bj < 2; ++bj)
#pragma unroll
                    for (int n = 0; n < 2; ++n) { const f32x4 xv = *(const f32x4*)(X + ro + bj * HALF + n * 16); *(f32x4*)(C + ro + bj * HALF + n * 16) = xv + gv[bj][n] * acc[ai][bj][m][n]; } }
    }
};
struct EpiSwiGLU {
    static constexpr bool PERM = true;
    bf16_t* H; int ldh;
    __device__ __forceinline__ void operator()(const f32x4 (&acc)[2][2][4][2], const Unit& u, int wr, int wc, int fr, int fq) const {
        const int row0 = u.pm * BM + wr * 64 + fr, col0 = u.pn * HALF + wc * 32 + 8 * fq;
#pragma unroll
        for (int ai = 0; ai < 2; ++ai)
#pragma unroll
            for (int m = 0; m < 4; ++m) { bf16_t* rowp = H + (size_t)(row0 + ai * HALF + m * 16) * ldh + col0;
                float hv[8];
#pragma unroll
                for (int n = 0; n < 2; ++n)
#pragma unroll
                    for (int j = 0; j < 4; ++j) { const float g = acc[ai][0][m][n][j], uu = acc[ai][1][m][n][j]; hv[n * 4 + j] = g * __builtin_amdgcn_rcpf(1.f + __builtin_amdgcn_exp2f(-1.4426950408889634f * g)) * uu; }
                u32x4 w; w.x = cvt_pk_bf16(hv[0], hv[1]); w.y = cvt_pk_bf16(hv[2], hv[3]); w.z = cvt_pk_bf16(hv[4], hv[5]); w.w = cvt_pk_bf16(hv[6], hv[7]);
                *(u32x4*)rowp = w; }
    }
};

template <class Epi, class Sched, bool GATHER>
__device__ __forceinline__ void gemm_phase(PG8_LAS unsigned char* lds, const bf16_t* Ab_, const int K, const PG8_LAS int* gidx, const Sched& S, const Epi& E) {
    int tid_ = threadIdx.x; asm volatile("" : "+v"(tid_));
    const int tid = tid_, wid = __builtin_amdgcn_readfirstlane(tid >> 6), lane = tid & 63, wr = wid >> 2, wc = wid & 3, fr = lane & 15, fq = lane >> 4;
    const int nt = K / BK;
    const char* Ab = (const char*)Ab_;
    int RA[2]; unsigned CA2[2], voffB[2];
#pragma unroll
    for (int i = 0; i < 2; ++i) { int R, C; stage_rc(tid * 16 + i * 8192, R, C); const int Rb = Epi::PERM ? ((R & ~31) + perm32(R & 31)) : R;
        RA[i] = R; CA2[i] = (unsigned)C * 2u; voffB[i] = (unsigned)(Rb * K + C) * 2u; }
    const unsigned rowbytes = (unsigned)K * 2u;
    const unsigned kstep = (unsigned)(BK * 2);
    const size_t hstep = (size_t)HALF * K * 2;
    const size_t tstep = 2 * hstep;
    const unsigned ldsw = (unsigned)wid * 1024u;
    const int aoff = lds_byte(wr * 64 + fr, fq * 8), boff = lds_byte(wc * 32 + fr, fq * 8);
#define PG8_SA(b, h) (((b) * 2 + (h)) * HTB)
#define PG8_SB(b, h) ((4 + (b) * 2 + (h)) * HTB)
#define PG8_STAGEB(bufoff, gbase) do { _Pragma("unroll") for (int _i = 0; _i < 2; ++_i) \
        __builtin_amdgcn_global_load_lds((const unsigned*)((const char*)(gbase) + voffB[_i]), (PG8_LAS unsigned*)(lds + (bufoff) + ldsw + _i * 8192), 16, 0, 0); } while (0)
#define PG8_STAGEA(bufoff, o0, o1) do { \
        __builtin_amdgcn_global_load_lds((const unsigned*)(Ab + (o0)), (PG8_LAS unsigned*)(lds + (bufoff) + ldsw), 16, 0, 0); \
        __builtin_amdgcn_global_load_lds((const unsigned*)(Ab + (o1)), (PG8_LAS unsigned*)(lds + (bufoff) + ldsw + 8192), 16, 0, 0); } while (0)
#define PG8_LDA(dst, b, h) do { _Pragma("unroll") for (int m = 0; m < 4; ++m) _Pragma("unroll") for (int k = 0; k < 2; ++k) dst[m][k] = *(const PG8_LAS bf16x8*)(lds + PG8_SA(b, h) + aoff + m * 2048 + k * 1024); } while (0)
#define PG8_LDB(dst, b, h) do { _Pragma("unroll") for (int n = 0; n < 2; ++n) _Pragma("unroll") for (int k = 0; k < 2; ++k) dst[n][k] = *(const PG8_LAS bf16x8*)(lds + PG8_SB(b, h) + boff + n * 2048 + k * 1024); } while (0)
#define PG8_MMA(ai, bj, At, Bt) do { __builtin_amdgcn_s_setprio(1); _Pragma("unroll") for (int m = 0; m < 4; ++m) _Pragma("unroll") for (int n = 0; n < 2; ++n) _Pragma("unroll") for (int k = 0; k < 2; ++k) \
        acc[ai][bj][m][n] = __builtin_amdgcn_mfma_f32_16x16x32_bf16(Bt[n][k], At[m][k], acc[ai][bj][m][n], 0, 0, 0); __builtin_amdgcn_s_setprio(0); } while (0)
#define PG8_WAIT_V(n) asm volatile("s_waitcnt vmcnt(" #n ")" ::: "memory")
#define PG8_WAIT_L(n) asm volatile("s_waitcnt lgkmcnt(" #n ")" ::: "memory")
#define PG8_BAR __builtin_amdgcn_s_barrier()
#define PG8_SCHED __builtin_amdgcn_sched_barrier(0)
#define PG8_MKOFF(dst, u, ui_) do { _Pragma("unroll") for (int h = 0; h < 2; ++h) _Pragma("unroll") for (int i = 0; i < 2; ++i) { \
        int row_ = (u).pm * BM + h * HALF + RA[i]; if (GATHER) row_ = gidx[(ui_) * BM + h * HALF + RA[i]]; dst[h][i] = (unsigned)row_ * rowbytes + CA2[i]; } } while (0)
    Unit cur, nxt; int ui = 0;
    if (!S.next(0, cur)) return;
    f32x4 acc[2][2][4][2];
#pragma unroll
    for (int a = 0; a < 2; ++a)
#pragma unroll
        for (int b = 0; b < 2; ++b)
#pragma unroll
            for (int m = 0; m < 4; ++m)
#pragma unroll
                for (int n = 0; n < 2; ++n) acc[a][b][m][n] = (f32x4){0.f, 0.f, 0.f, 0.f};
    bf16x8 At[4][2], B0[2][2], B1[2][2];
    unsigned curo[2][2], nxto[2][2];
    PG8_MKOFF(curo, cur, 0);
    const char* cB = (const char*)cur.Bt + (size_t)cur.pn * tstep;
    PG8_STAGEB(PG8_SB(0, 0), cB); PG8_STAGEB(PG8_SB(0, 1), cB + hstep); PG8_STAGEA(PG8_SA(0, 0), curo[0][0], curo[0][1]); PG8_STAGEA(PG8_SA(0, 1), curo[1][0], curo[1][1]);
    if (wr == 1) PG8_BAR;
    PG8_WAIT_V(2); PG8_BAR;
    PG8_STAGEB(PG8_SB(1, 0), cB + kstep); PG8_STAGEA(PG8_SA(1, 0), curo[0][0] + kstep, curo[0][1] + kstep); PG8_STAGEB(PG8_SB(1, 1), cB + hstep + kstep);
    PG8_WAIT_V(6); PG8_BAR;
    for (;;) {
        const bool has_next = S.next(ui + 1, nxt);
        if (has_next) { PG8_MKOFF(nxto, nxt, ui + 1); } else {
#pragma unroll
            for (int h = 0; h < 2; ++h)
#pragma unroll
                for (int i = 0; i < 2; ++i) nxto[h][i] = curo[h][i]; }
        const char* nB = has_next ? (const char*)nxt.Bt + (size_t)nxt.pn * tstep : cB;
        for (int t = 0; t < nt; t += 2) {
            const bool last = (t == nt - 2);
            const unsigned kb1 = (unsigned)(t + 1) * kstep, kb2 = last ? 0u : (unsigned)(t + 2) * kstep, kb3 = kb2 + kstep;
            const unsigned s00 = last ? nxto[0][0] : curo[0][0], s01 = last ? nxto[0][1] : curo[0][1], s10 = last ? nxto[1][0] : curo[1][0], s11 = last ? nxto[1][1] : curo[1][1];
            const char* b2 = last ? nB : cB + (size_t)(t + 2) * kstep; const char* b3 = b2 + kstep;
            PG8_LDB(B0, 0, 0); PG8_LDB(B1, 0, 1); PG8_SCHED; PG8_LDA(At, 0, 0); PG8_STAGEA(PG8_SA(1, 1), curo[1][0] + kb1, curo[1][1] + kb1);
            PG8_WAIT_V(8); PG8_WAIT_L(0); PG8_BAR; PG8_MMA(0, 0, At, B0); PG8_MMA(0, 1, At, B1); PG8_BAR; PG8_SCHED;
            PG8_LDA(At, 0, 1); PG8_STAGEB(PG8_SB(0, 0), b2); PG8_STAGEB(PG8_SB(0, 1), b2 + hstep); PG8_STAGEA(PG8_SA(0, 0), s00 + kb2, s01 + kb2);
            PG8_WAIT_V(8); PG8_WAIT_L(0); PG8_BAR; PG8_MMA(1, 0, At, B0); PG8_MMA(1, 1, At, B1); PG8_BAR; PG8_SCHED;
            PG8_LDB(B0, 1, 0); PG8_LDB(B1, 1, 1); PG8_SCHED; PG8_LDA(At, 1, 0); PG8_STAGEA(PG8_SA(0, 1), s10 + kb2, s11 + kb2);
            PG8_WAIT_V(8); PG8_WAIT_L(0); PG8_BAR; PG8_MMA(0, 0, At, B0); PG8_MMA(0, 1, At, B1); PG8_BAR; PG8_SCHED;
            PG8_LDA(At, 1, 1); PG8_STAGEB(PG8_SB(1, 0), b3); PG8_STAGEB(PG8_SB(1, 1), b3 + hstep); PG8_STAGEA(PG8_SA(1, 0), s00 + kb3, s01 + kb3);
            PG8_WAIT_V(8); PG8_WAIT_L(0); PG8_BAR; PG8_MMA(1, 0, At, B0); PG8_MMA(1, 1, At, B1); PG8_BAR; PG8_SCHED;
        }
        if (wr == 0) PG8_BAR;
        E(acc, cur, wr, wc, fr, fq);
        if (!has_next) break;
#pragma unroll
        for (int a = 0; a < 2; ++a)
#pragma unroll
            for (int b = 0; b < 2; ++b)
#pragma unroll
                for (int m = 0; m < 4; ++m)
#pragma unroll
                    for (int n = 0; n < 2; ++n) acc[a][b][m][n] = (f32x4){0.f, 0.f, 0.f, 0.f};
        cur = nxt; cB = nB; ++ui;
#pragma unroll
        for (int h = 0; h < 2; ++h)
#pragma unroll
            for (int i = 0; i < 2; ++i) curo[h][i] = nxto[h][i];
        if (wr == 1) PG8_BAR;
    }
    PG8_WAIT_V(0);
    PG8_BAR;
#undef PG8_SA
#undef PG8_SB
#undef PG8_STAGEA
#undef PG8_STAGEB
#undef PG8_LDA
#undef PG8_LDB
#undef PG8_MMA
#undef PG8_WAIT_V
#undef PG8_WAIT_L
#undef PG8_BAR
#undef PG8_SCHED
#undef PG8_MKOFF
}
}

constexpr int NWAVES = 8, NTHR = NWAVES * 64;
constexpr int D = 1024, BATCH = 8, SEQ = 2048, NTOK = BATCH * SEQ, DEPTH = 2;
constexpr int NG = 4, EPG = 8, NE = 32, FH = 512, NPAIR = NTOK * 2;
constexpr int MAX_SLOTS = NPAIR + NE * 256;
constexpr int MAX_TILES = MAX_SLOTS / 256;
constexpr int NPHASE = 2 + 8 * DEPTH;
constexpr float C2 = 0.125f * 1.4426950408889634f;
constexpr float LOG2E = 1.4426950408889634f, LN2 = 0.6931471805599453f;

constexpr size_t MiB = 1u << 20;
constexpr size_t WS_CTL = 0, CTL_ZERO_BYTES = 1 * MiB;
constexpr size_t WS_MOD = 1 * MiB;
constexpr size_t WS_EID = 2 * MiB, WS_EW = 3 * MiB, WS_HIST = 4 * MiB, WS_SOP = 5 * MiB, WS_STOK = 6 * MiB, WS_TILES = 7 * MiB;
constexpr size_t LSTRIDE = 512 * 1024;
constexpr size_t WS_W = 8 * MiB, W_LAYER = 104 * MiB, W_IN = 0, W_OUT = 6 * MiB, W_GU = 8 * MiB, W_DN = 72 * MiB;
constexpr size_t WS_XN = 216 * MiB;
constexpr size_t WS_Q = 248 * MiB, WS_K = 280 * MiB, WS_V = 312 * MiB, WS_O = 344 * MiB;
constexpr size_t WS_HM = 248 * MiB;
constexpr size_t WS_YD = 288 * MiB;
constexpr size_t WS_END = 376 * MiB;
constexpr int CW_BAR = 4096;
constexpr int RING_BYTES = 131072, AUX_OFF = 131072, MISC_OFF = 147456, LDS_BYTES = 163840;

#define GAS __attribute__((address_space(1)))
#define LAS __attribute__((address_space(3)))
typedef unsigned short bf16;
typedef unsigned v4u __attribute__((ext_vector_type(4)));
typedef unsigned v2u __attribute__((ext_vector_type(2)));
typedef float f32x4 __attribute__((ext_vector_type(4)));
typedef GAS unsigned gu32;
#define RLX_AGENT __ATOMIC_RELAXED, __HIP_MEMORY_SCOPE_AGENT
#define LDS_WAIT() asm volatile("s_waitcnt lgkmcnt(0)" ::: "memory")
__device__ __forceinline__ unsigned f2bf(float f) { unsigned u = __builtin_bit_cast(unsigned, f); return (u + 0x7fffu + ((u >> 16) & 1u)) >> 16; }
__device__ __forceinline__ unsigned pk2(float lo, float hi) { return f2bf(lo) | (f2bf(hi) << 16); }
__device__ __forceinline__ float bf_lo(unsigned w) { return __builtin_bit_cast(float, w << 16); }
__device__ __forceinline__ float bf_hi(unsigned w) { return __builtin_bit_cast(float, w & 0xffff0000u); }
__device__ __forceinline__ int vzero() { int z = 0; asm volatile("" : "+v"(z)); return z; }

#define XB_TMO      128
#define XB_XCNT(j)  (256  + 64 * (j))
#define XB_XSUB(j)  (1280 + 64 * (j))
#define XB_XGEN(j)  (2304 + 64 * (j))
#define XB_TOP      3328
#define XB_TOPGEN   3392
#define XCD_BAR_WORDS 3456
#define XB_SPIN_CAP (1u << 18)
__device__ __forceinline__ unsigned xb_ld(unsigned* p)              { return __hip_atomic_load(p, __ATOMIC_RELAXED, __HIP_MEMORY_SCOPE_AGENT); }
__device__ __forceinline__ unsigned xb_add(unsigned* p, unsigned v) { return __hip_atomic_fetch_add(p, v, __ATOMIC_RELAXED, __HIP_MEMORY_SCOPE_AGENT); }
__device__ __forceinline__ unsigned xb_xcc_id() { return (unsigned)__builtin_amdgcn_s_getreg((3 << 11) | 20) & 0xFu; }
#define XB_SPIN(cond, bar) do { unsigned _sp = 0; while (cond) { __builtin_amdgcn_s_sleep(1); \
    if ((++_sp & 255u) == 0u) { if (xb_ld(&(bar)[XB_TMO])) break; if (_sp > XB_SPIN_CAP) { atomicAdd(&(bar)[XB_TMO], 1u); break; } } } } while (0)
struct XcdBarrier { unsigned* bar; unsigned x; volatile LAS unsigned* st; };
__device__ __forceinline__ XcdBarrier xcd_barrier_post(unsigned* bar, volatile LAS unsigned* st) {
    XcdBarrier b; b.bar = bar; b.x = xb_xcc_id(); b.st = st;
    if (threadIdx.x == 0) (void)xb_add(&bar[XB_XCNT(b.x)], 1u);
    return b;
}
__device__ __forceinline__ void xcd_barrier_complete(unsigned* bar, unsigned x, unsigned& nloc, unsigned& nx) {
    const unsigned G = gridDim.x * gridDim.y * gridDim.z;
    unsigned sum, cnt, mine, sp = 0u;
    for (;;) {
        sum = 0u; cnt = 0u; mine = 0u;
#pragma unroll
        for (unsigned j = 0; j < 16; ++j) { const unsigned c = xb_ld(&bar[XB_XCNT(j)]); sum += c; cnt += (c > 0u) ? 1u : 0u; mine = (j == x) ? c : mine; }
        if (sum == G) break;
        __builtin_amdgcn_s_sleep(1);
        if ((++sp & 255u) == 0u) { if (xb_ld(&bar[XB_TMO])) break; if (sp > XB_SPIN_CAP) { atomicAdd(&bar[XB_TMO], 1u); break; } }
    }
    nloc = mine > 0u ? mine : 1u; nx = cnt > 0u ? cnt : 1u;
}
__device__ __forceinline__ void xcd_barrier(const XcdBarrier& b) {
    asm volatile("s_waitcnt vmcnt(0)" ::: "memory");
    __syncthreads();
    if (threadIdx.x == 0) {
        unsigned* bar = b.bar;
        __builtin_amdgcn_s_waitcnt(0);
        unsigned nloc = b.st[0], nx = b.st[1];
        if (nloc == 0u) { xcd_barrier_complete(bar, b.x, nloc, nx); b.st[0] = nloc; b.st[1] = nx; }
        const unsigned old = xb_add(&bar[XB_XSUB(b.x)], 1u);
        const unsigned gen = old / nloc;
        if (old + 1u == (gen + 1u) * nloc) {
            __builtin_amdgcn_fence(__ATOMIC_RELEASE, "agent");
            asm volatile("s_waitcnt vmcnt(0)" ::: "memory");
            const unsigned og = xb_add(&bar[XB_TOP], 1u);
            const unsigned tg = og / nx;
            if (og + 1u == (tg + 1u) * nx) xb_add(&bar[XB_TOPGEN], 1u);
            else XB_SPIN(xb_ld(&bar[XB_TOPGEN]) == tg, bar);
            __builtin_amdgcn_fence(__ATOMIC_ACQUIRE, "agent");
            xb_add(&bar[XB_XGEN(b.x)], 1u);
            asm volatile("s_waitcnt vmcnt(0)" ::: "memory");
        } else {
            XB_SPIN(xb_ld(&bar[XB_XGEN(b.x)]) == gen, bar);
            __builtin_amdgcn_fence(__ATOMIC_ACQUIRE, "agent");
            asm volatile("s_waitcnt vmcnt(0)" ::: "memory");
        }
    }
    __syncthreads();
}

__device__ __forceinline__ float wave_sum(float v) {
#pragma unroll
    for (int o = 1; o < 64; o <<= 1) v += __shfl_xor(v, o);
    return v;
}
__device__ __forceinline__ float wave_max(float v) {
#pragma unroll
    for (int o = 1; o < 64; o <<= 1) v = fmaxf(v, __shfl_xor(v, o));
    return v;
}
__device__ __forceinline__ void transpose_item(const float* W, int K, int N, bf16* WT, int drow, LAS float* scr, int k0, int n0, int lane) {
#pragma unroll 8
    for (int i = 0; i < 32; ++i) { const int kk = 2 * i + (lane >> 5); scr[kk * 33 + (lane & 31)] = W[(size_t)(k0 + kk) * N + n0 + (lane & 31)]; }
    LDS_WAIT(); asm volatile("" ::: "memory");
    const int c = lane & 7;
#pragma unroll
    for (int j = 0; j < 4; ++j) { const int n = (lane >> 3) + 8 * j; const LAS float* s = scr + (8 * c) * 33 + n;
        v4u o; o.x = pk2(s[0 * 33], s[1 * 33]); o.y = pk2(s[2 * 33], s[3 * 33]); o.z = pk2(s[4 * 33], s[5 * 33]); o.w = pk2(s[6 * 33], s[7 * 33]);
        *(GAS v4u*)(WT + (size_t)(drow + n) * K + k0 + 8 * c) = o; }
    LDS_WAIT(); asm volatile("" ::: "memory");
}
__device__ __forceinline__ void norm_mod(f32x4 (&v)[4], const float* g, const float* sh, const float* sc, int lane, float eps) {
    float ss = 0.f;
#pragma unroll
    for (int j = 0; j < 4; ++j) ss += (v[j].x * v[j].x + v[j].y * v[j].y) + (v[j].z * v[j].z + v[j].w * v[j].w);
    const float r = 1.0f / sqrtf(wave_sum(ss) * (1.f / D) + eps);
#pragma unroll
    for (int j = 0; j < 4; ++j) {
        const int c0 = 4 * lane + 256 * j;
        const f32x4 gg = *(const f32x4*)(g + c0);
        v[j] = v[j] * r * gg;
        if (sc) { const f32x4 s1 = *(const f32x4*)(sc + c0), s0 = *(const f32x4*)(sh + c0); v[j] = v[j] * (1.f + s1) + s0; }
    }
}
__device__ __forceinline__ void store_row_bf16(bf16* orow, const f32x4 (&v)[4], int lane) {
    GAS unsigned long long* o8 = (GAS unsigned long long*)orow + lane;
#pragma unroll
    for (int j = 0; j < 4; ++j) o8[64 * j] = (unsigned long long)pk2(v[j].x, v[j].y) | ((unsigned long long)pk2(v[j].z, v[j].w) << 32);
}
__device__ __forceinline__ float dot8(const v4u kv, const LAS float* q) {
    return bf_lo(kv.x) * q[0] + bf_hi(kv.x) * q[1] + bf_lo(kv.y) * q[2] + bf_hi(kv.y) * q[3] + bf_lo(kv.z) * q[4] + bf_hi(kv.z) * q[5] + bf_lo(kv.w) * q[6] + bf_hi(kv.w) * q[7];
}

struct Args {
    const float* in[23]; float* out; unsigned char* ws; int ph_lo, ph_hi;
};

__global__ void __launch_bounds__(NTHR, 2) fwd(Args args) {
    extern __shared__ __attribute__((aligned(16))) unsigned char lds_raw[];
    LAS unsigned char* lds = (LAS unsigned char*)lds_raw;
    volatile LAS unsigned* MISC = (volatile LAS unsigned*)(lds + MISC_OFF);
    const int G = gridDim.x, bx = blockIdx.x;
#define PHASE_IDS() int tid = threadIdx.x; asm volatile("" : "+v"(tid)); const int lane = tid & 63, wave = __builtin_amdgcn_readfirstlane(tid >> 6); const int gw = vcu * NWAVES + wave; (void)lane; (void)gw
    const int vcu = (G % 8 == 0) ? (bx % 8) * (G / 8) + bx / 8 : bx;
    unsigned char* ws = args.ws;
    gu32* ctl = (gu32*)(ws + WS_CTL);
    for (int u = threadIdx.x; u < (LDS_BYTES - MISC_OFF) / 4; u += NTHR) ((LAS unsigned*)(lds + MISC_OFF))[u] = 0u;
    __syncthreads();
    XcdBarrier bar; bar.bar = (unsigned*)ctl + CW_BAR; bar.x = 0; bar.st = nullptr;
    if (MK_ONE_LAUNCH) bar = xcd_barrier_post((unsigned*)ctl + CW_BAR, MISC + 8);
#define GRID_BAR() do { if (MK_ONE_LAUNCH) xcd_barrier(bar); } while (0)
    const int lo = args.ph_lo, hi = args.ph_hi;
#define IN(k) (lo <= (k) && (k) < hi)
#define BOTH(k) (IN(k) && IN((k) + 1))
    const float* x_in = args.in[0]; const float* c_in = args.in[1];
    const float* norm1_g = args.in[2]; const float* norm2_g = args.in[3];
    const float* ada_w = args.in[4]; const float* ada_b = args.in[5];
    float* xs = args.out;
    float* mod = (float*)(ws + WS_MOD);
    bf16* XN = (bf16*)(ws + WS_XN); bf16* Qb = (bf16*)(ws + WS_Q); bf16* Kb = (bf16*)(ws + WS_K); bf16* Vb = (bf16*)(ws + WS_V); bf16* Ob = (bf16*)(ws + WS_O);
    bf16* Hm = (bf16*)(ws + WS_HM); bf16* Yd = (bf16*)(ws + WS_YD);
    const int NGW = G * NWAVES;

    if (IN(0)) {
            PHASE_IDS();
        if (bx < 192) {
            LAS float* cond = (LAS float*)lds; LAS float* red = (LAS float*)(lds + 32768);
            const int l = bx / 96, j0 = (bx % 96) * 64;
            for (int i = tid; i < BATCH * D; i += NTHR) { const float v = c_in[i]; cond[i] = v / (1.f + __expf(-v)); }
            __syncthreads();
            float acc[BATCH];
#pragma unroll
            for (int b = 0; b < BATCH; ++b) acc[b] = 0.f;
            const float* W = ada_w + (size_t)l * D * 6 * D + j0 + lane;
#pragma unroll 8
            for (int k = wave * 128; k < wave * 128 + 128; ++k) {
                const float w = W[(size_t)k * 6 * D];
#pragma unroll
                for (int b = 0; b < BATCH; ++b) acc[b] += cond[b * D + k] * w;
            }
#pragma unroll
            for (int b = 0; b < BATCH; ++b) red[(wave * BATCH + b) * 64 + lane] = acc[b];
            __syncthreads();
            { const int b = tid >> 6, j = tid & 63; float s = ada_b[(size_t)l * 6 * D + j0 + j];
#pragma unroll
              for (int w = 0; w < NWAVES; ++w) s += red[(w * BATCH + b) * 64 + j];
              mod[((size_t)l * BATCH + b) * 6 * D + j0 + j] = s; }
        }
        if (BOTH(0)) GRID_BAR();
    }

    if (IN(1)) {
            PHASE_IDS();
        LAS float* scr = (LAS float*)(lds + wave * 16384);
        constexpr int I_IN = 16 * 96, I_OUT = 16 * 32, I_G = 32 * 256, I_D = 32 * 256, I_LAYER = I_IN + I_OUT + 2 * I_G + I_D;
        for (int it = gw; it < DEPTH * I_LAYER; it += NGW) {
            const int l = it / I_LAYER; int r = it % I_LAYER;
            unsigned char* wl = ws + WS_W + (size_t)l * W_LAYER;
            if (r < I_IN) { const float* W = args.in[l == 0 ? 6 : 13]; transpose_item(W, D, 3 * D, (bf16*)(wl + W_IN), 32 * (r % 96), scr, 64 * (r / 96), 32 * (r % 96), lane); continue; } r -= I_IN;
            if (r < I_OUT) { const float* W = args.in[l == 0 ? 7 : 14]; transpose_item(W, D, D, (bf16*)(wl + W_OUT), 32 * (r % 32), scr, 64 * (r / 32), 32 * (r % 32), lane); continue; } r -= I_OUT;
            if (r < 2 * I_G) { const int up = r / I_G; r %= I_G; const int e = r / 256, rr = r % 256, n0 = 32 * (rr % 16);
                const float* W = args.in[up ? 20 : 19] + ((size_t)l * NE + e) * D * FH;
                transpose_item(W, D, FH, (bf16*)(wl + W_GU) + (size_t)e * D * D, (n0 / 128) * 256 + (n0 % 128) + up * 128, scr, 64 * (rr / 16), n0, lane); continue; } r -= 2 * I_G;
            { const int e = r / 256, rr = r % 256; const float* W = args.in[21] + ((size_t)l * NE + e) * FH * D;
              transpose_item(W, FH, D, (bf16*)(wl + W_DN) + (size_t)e * D * FH, 32 * (rr % 32), scr, 64 * (rr / 32), 32 * (rr % 32), lane); }
        }
        for (int m = gw; m < NTOK; m += NGW) {
            const int b = m / SEQ; const float* mb = mod + (size_t)b * 6 * D;
            f32x4 v[4]; const GAS f32x4* xr = (const GAS f32x4*)(x_in + (size_t)m * D) + lane;
#pragma unroll
            for (int j = 0; j < 4; ++j) v[j] = xr[64 * j];
            norm_mod(v, norm1_g, mb, mb + D, lane, 1e-6f);
            store_row_bf16(XN + (size_t)m * D, v, lane);
        }
        if (BOTH(1)) GRID_BAR();
    }

#pragma unroll 1
    for (int l = 0; l < DEPTH; ++l) {
        const int pb = 2 + 8 * l;
        unsigned char* wl = ws + WS_W + (size_t)l * W_LAYER;
        const float* modl = mod + (size_t)l * BATCH * 6 * D;
        int* eid = (int*)(ws + WS_EID + l * LSTRIDE); float* ew = (float*)(ws + WS_EW + l * LSTRIDE); int* hist = (int*)(ws + WS_HIST + l * LSTRIDE);
        int* sop = (int*)(ws + WS_SOP + l * LSTRIDE); int* stok = (int*)(ws + WS_STOK + l * LSTRIDE); int* tiles = (int*)(ws + WS_TILES + l * LSTRIDE);

        if (IN(pb + 0)) {
            PHASE_IDS();
            pg8::StaticOrder S; S.init(NTOK, 3 * D, G, bx, (const bf16*)(wl + W_IN));
            pg8::EpiBf16 E{Qb, D, D, (size_t)(WS_K - WS_Q) / 2, C2};
            pg8::gemm_phase<pg8::EpiBf16, pg8::StaticOrder, false>(lds, XN, D, nullptr, S, E);
            if (BOTH(pb + 0)) GRID_BAR();
        }
        if (IN(pb + 1)) {
            PHASE_IDS();
            if (l == 0) {
                LAS float* s1 = (LAS float*)(lds + wave * 16384); LAS float* s2 = s1 + SEQ; LAS float* sq = (LAS float*)(lds + AUX_OFF + wave * 512);
                const float* lq1 = args.in[8]; const float* lk1 = args.in[9]; const float* lq2 = args.in[10]; const float* lk2 = args.in[11]; const float* subg = args.in[12];
                const float lam = __expf(wave_sum(lq1[lane] * lk1[lane])) - __expf(wave_sum(lq2[lane] * lk2[lane])) + 0.2f;
                for (int bh = 0; bh < 64; ++bh) {
                    const int tq = (bh & 1) ? (SEQ - 1 - gw) : gw;
                    const int b = bh >> 3, h = bh & 7;
                    const size_t rb = (size_t)b * SEQ;
                    { const bf16* qp = Qb + (rb + tq) * D + h * 128; const unsigned w = ((const unsigned*)qp)[lane]; sq[2 * lane] = bf_lo(w); sq[2 * lane + 1] = bf_hi(w); }
                    LDS_WAIT();
                    const float slope2 = exp2f(-(float)(h + 1)) * LOG2E;
                    const int nk = (tq / 64 + 1) * 64;
                    float m1 = -INFINITY, m2 = -INFINITY;
                    for (int s = lane; s < nk; s += 64) {
                        const v4u* kp = (const v4u*)(Kb + (rb + s) * D + h * 128);
                        float d1 = 0.f, d2 = 0.f;
#pragma unroll
                        for (int c = 0; c < 8; ++c) { d1 += dot8(kp[c], sq + 8 * c); d2 += dot8(kp[8 + c], sq + 64 + 8 * c); }
                        const float bias = slope2 * fabsf((float)(tq - s));
                        const float a1 = d1 - bias, a2 = d2 - bias;
                        s1[s] = a1; s2[s] = a2; m1 = fmaxf(m1, a1); m2 = fmaxf(m2, a2);
                    }
                    m1 = wave_max(m1); m2 = wave_max(m2);
                    float z1 = 0.f, z2 = 0.f;
                    for (int s = lane; s < nk; s += 64) { const float e1 = exp2f(s1[s] - m1), e2 = exp2f(s2[s] - m2); s1[s] = e1; s2[s] = e2; z1 += e1; z2 += e2; }
                    z1 = wave_sum(z1); z2 = wave_sum(z2);
                    const float r1 = 1.f / z1, r2 = lam / z2;
                    for (int s = lane; s < nk; s += 64) s1[s] = s1[s] * r1 - s2[s] * r2;
                    LDS_WAIT();
                    float o0 = 0.f, o1 = 0.f;
                    const bf16* vp = Vb + rb * D + h * 128 + 2 * lane;
                    for (int s = 0; s < nk; ++s) { const float a = s1[s]; const unsigned w = *(const unsigned*)(vp + (size_t)s * D); o0 += a * bf_lo(w); o1 += a * bf_hi(w); }
                    const float ss = wave_sum(o0 * o0 + o1 * o1) * (1.f / 128.f);
                    const float r = 0.8f / sqrtf(ss + 1e-5f);
                    ((unsigned*)(Ob + (rb + tq) * D + h * 128))[lane] = pk2(o0 * r * subg[2 * lane], o1 * r * subg[2 * lane + 1]);
                    LDS_WAIT();
                }
            } else {
                LAS float* zz = (LAS float*)(lds + wave * 16384); LAS float* sq = (LAS float*)(lds + AUX_OFF + wave * 512);
                for (int bh = 0; bh < 128; ++bh) {
                    const int t = (bh & 1) ? (SEQ - 1 - gw) : gw;
                    const int b = bh >> 4, h = bh & 15;
                    const size_t rb = (size_t)b * SEQ;
                    sq[lane] = (lane & 1) ? bf_hi(((const unsigned*)(Qb + (rb + t) * D + h * 64))[lane >> 1]) : bf_lo(((const unsigned*)(Qb + (rb + t) * D + h * 64))[lane >> 1]);
                    LDS_WAIT();
                    const int s0 = lane * 32;
                    float seg = 0.f;
                    for (int i = 0; i < 32; ++i) { const int s = s0 + i;
                        if (s < t) { const v4u* kp = (const v4u*)(Kb + (rb + s) * D + h * 64); float d = 0.f;
#pragma unroll
                            for (int c = 0; c < 8; ++c) d += dot8(kp[c], sq + 8 * c);
                            const float z = d * LN2; zz[s] = z; seg += -(fmaxf(z, 0.f) + log1pf(__expf(-fabsf(z)))); } }
                    float incl = seg;
#pragma unroll
                    for (int o = 1; o < 64; o <<= 1) { const float v = __shfl_down(incl, o); if (lane + o < 64) incl += v; }
                    float run = incl - seg;
                    for (int i = 31; i >= 0; --i) { const int s = s0 + i;
                        if (s < t) { const float z = zz[s]; const float lf = -(fmaxf(z, 0.f) + log1pf(__expf(-fabsf(z)))); zz[s] = __expf(z + lf + run); run += lf; } }
                    LDS_WAIT();
                    float o = 0.f;
                    const bf16* vp = Vb + rb * D + h * 64 + lane;
                    for (int s = 0; s < t; ++s) o += zz[s] * bf_lo((unsigned)vp[(size_t)s * D]);
                    Ob[(rb + t) * D + h * 64 + lane] = (bf16)f2bf(o);
                    LDS_WAIT();
                }
            }
            if (BOTH(pb + 1)) GRID_BAR();
        }
        if (IN(pb + 2)) {
            PHASE_IDS();
            pg8::StaticOrder S; S.init(NTOK, D, G, bx, (const bf16*)(wl + W_OUT));
            pg8::EpiResid E{xs, l == 0 ? x_in : xs, D, modl + 2 * D, 6 * D, SEQ};
            pg8::gemm_phase<pg8::EpiResid, pg8::StaticOrder, false>(lds, Ob, D, nullptr, S, E);
            if (BOTH(pb + 2)) GRID_BAR();
        }
        if (IN(pb + 3)) {
            PHASE_IDS();
            LAS float* wl_ = (LAS float*)lds;
            LAS int* lhist = (LAS int*)(lds + MISC_OFF + 256);
            const float* rgw = args.in[15] + (size_t)l * D * NG; const float* rgb = args.in[16] + l * NG; const float* rew = args.in[17] + (size_t)l * D * NE; const float* reb = args.in[18] + l * NE;
            for (int i = tid; i < D * NG; i += NTHR) wl_[(i & 3) * D + (i >> 2)] = rgw[i];
            for (int i = tid; i < D * NE; i += NTHR) wl_[(4 + (i & 31)) * D + (i >> 5)] = rew[i];
            if (tid < NE) lhist[tid] = 0;
            __syncthreads();
            for (int i = 0; i < 8; ++i) {
                const int tok = bx * 64 + wave * 8 + i;
                const int b = tok / SEQ; const float* mb = modl + (size_t)b * 6 * D;
                f32x4 v[4]; const GAS f32x4* xr = (const GAS f32x4*)(xs + (size_t)tok * D) + lane;
#pragma unroll
                for (int j = 0; j < 4; ++j) v[j] = xr[64 * j];
                norm_mod(v, norm2_g + l * D, mb + 3 * D, mb + 4 * D, lane, 1e-6f);
                store_row_bf16(XN + (size_t)tok * D, v, lane);
                float gl[4];
#pragma unroll
                for (int g = 0; g < 4; ++g) { float s = 0.f;
#pragma unroll
                    for (int j = 0; j < 4; ++j) { const f32x4 w = *(const LAS f32x4*)(wl_ + g * D + 4 * lane + 256 * j); s += (v[j].x * w.x + v[j].y * w.y) + (v[j].z * w.z + v[j].w * w.w); }
                    gl[g] = wave_sum(s) + rgb[g]; }
                int gi = 0; float gm = gl[0];
#pragma unroll
                for (int g = 1; g < 4; ++g) if (gl[g] > gm) { gm = gl[g]; gi = g; }
                float gs = 0.f;
#pragma unroll
                for (int g = 0; g < 4; ++g) gs += __expf(gl[g] - gm);
                const float gwt = 1.0f / gs;
                gi = __builtin_amdgcn_readfirstlane(gi);
                float v1 = -INFINITY, v2 = -INFINITY; int i1 = 0, i2 = 0;
#pragma unroll
                for (int jx = 0; jx < 8; ++jx) { float s = 0.f; const LAS float* wr_ = wl_ + (4 + gi * 8 + jx) * D;
#pragma unroll
                    for (int j = 0; j < 4; ++j) { const f32x4 w = *(const LAS f32x4*)(wr_ + 4 * lane + 256 * j); s += (v[j].x * w.x + v[j].y * w.y) + (v[j].z * w.z + v[j].w * w.w); }
                    const float ev = wave_sum(s) + reb[gi * 8 + jx];
                    if (ev > v1) { v2 = v1; i2 = i1; v1 = ev; i1 = jx; } else if (ev > v2) { v2 = ev; i2 = jx; } }
                if (lane == 0) {
                    const float e2 = __expf(v2 - v1), den = 1.f / (1.f + e2);
                    eid[tok * 2] = gi * 8 + i1; eid[tok * 2 + 1] = gi * 8 + i2; ew[tok * 2] = gwt * den; ew[tok * 2 + 1] = gwt * e2 * den;
                    atomicAdd((int*)(lhist + gi * 8 + i1), 1); atomicAdd((int*)(lhist + gi * 8 + i2), 1);
                }
            }
            __syncthreads();
            if (tid < NE) hist[bx * NE + tid] = lhist[tid];
            if (BOTH(pb + 3)) GRID_BAR();
        }
        if (IN(pb + 4)) {
            PHASE_IDS();
            LAS int* tot = (LAS int*)lds; LAS int* bef = tot + 16 * NE; LAS int* pst = bef + 16 * NE; LAS int* tote = pst + 64; LAS int* befe = tote + 32; LAS int* le = befe + 32;
            { const int e = tid & 31, part = tid >> 5; int s = 0, sb = 0;
              for (int w = part * 16; w < part * 16 + 16; ++w) { const int hv = hist[w * NE + e]; s += hv; if (w < bx) sb += hv; }
              tot[part * NE + e] = s; bef[part * NE + e] = sb; }
            __syncthreads();
            if (tid < NE) { int s = 0, sb = 0; for (int p = 0; p < 16; ++p) { s += tot[p * NE + tid]; sb += bef[p * NE + tid]; } tote[tid] = s; befe[tid] = sb; }
            __syncthreads();
            if (tid == 0) { int off = 0; for (int e = 0; e < NE; ++e) { pst[e] = off; off += (tote[e] + 255) / 256 * 256; } pst[NE] = off; }
            if (tid < 128) le[tid] = eid[(bx * 64) * 2 + tid];
            __syncthreads();
            if (tid < 128) { const int e = le[tid]; int rank = 0; for (int q = 0; q < tid; ++q) rank += (le[q] == e) ? 1 : 0;
                const int s = pst[e] + befe[e] + rank; stok[s] = bx * 64 + (tid >> 1); sop[(bx * 64) * 2 + tid] = s; }
            if (bx < NE) { const int e = bx; for (int s = pst[e] + tote[e] + tid; s < pst[e + 1]; s += NTHR) stok[s] = 0; }
            if (bx == NE) { if (tid < NE) { for (int t = pst[tid] / 256; t < pst[tid + 1] / 256; ++t) tiles[1 + t] = tid; } if (tid == 0) tiles[0] = pst[NE] / 256; }
            if (BOTH(pb + 4)) GRID_BAR();
        }
        if (IN(pb + 5)) {
            PHASE_IDS();
            LAS int* tl = (LAS int*)(lds + AUX_OFF); LAS int* gidx = tl + 256;
            if (tid < 1 + MAX_TILES) tl[tid] = tiles[tid + vzero()];
            __syncthreads();
            pg8::GroupedOrder S{tl, G, vcu, (const bf16*)(wl + W_GU), (size_t)D * D};
            { pg8::Unit u; for (int i = 0; i < 3 && S.next(i, u); ++i) { if (tid < 256) gidx[i * 256 + tid] = stok[u.pm * 256 + tid]; } }
            __syncthreads();
            pg8::EpiSwiGLU E{Hm, FH};
            pg8::gemm_phase<pg8::EpiSwiGLU, pg8::GroupedOrder, true>(lds, XN, D, gidx, S, E);
            if (BOTH(pb + 5)) GRID_BAR();
        }
        if (IN(pb + 6)) {
            PHASE_IDS();
            LAS int* tl = (LAS int*)(lds + AUX_OFF);
            if (tid < 1 + MAX_TILES) tl[tid] = tiles[tid + vzero()];
            __syncthreads();
            pg8::GroupedOrder S{tl, G, vcu, (const bf16*)(wl + W_DN), (size_t)D * FH};
            pg8::EpiBf16 E{Yd, D, 0, 0, 1.f};
            pg8::gemm_phase<pg8::EpiBf16, pg8::GroupedOrder, false>(lds, Hm, FH, nullptr, S, E);
            if (BOTH(pb + 6)) GRID_BAR();
        }
        if (IN(pb + 7)) {
            PHASE_IDS();
            for (int m = gw; m < NTOK; m += NGW) {
                const int b = m / SEQ; const float* mb = modl + (size_t)b * 6 * D;
                const int vz = vzero();
                const int s0 = sop[m * 2 + vz], s1 = sop[m * 2 + 1 + vz]; const float w0 = ew[m * 2 + vz], w1 = ew[m * 2 + 1 + vz];
                f32x4 v[4]; GAS f32x4* xr = (GAS f32x4*)(xs + (size_t)m * D) + lane;
                const GAS v2u* y0 = (const GAS v2u*)(Yd + (size_t)s0 * D) + lane; const GAS v2u* y1 = (const GAS v2u*)(Yd + (size_t)s1 * D) + lane;
#pragma unroll
                for (int j = 0; j < 4; ++j) {
                    const f32x4 xv = xr[64 * j]; const v2u a = y0[64 * j], c = y1[64 * j]; const f32x4 g2 = *(const f32x4*)(mb + 5 * D + 4 * lane + 256 * j);
                    f32x4 y; y.x = w0 * bf_lo(a.x) + w1 * bf_lo(c.x); y.y = w0 * bf_hi(a.x) + w1 * bf_hi(c.x); y.z = w0 * bf_lo(a.y) + w1 * bf_lo(c.y); y.w = w0 * bf_hi(a.y) + w1 * bf_hi(c.y);
                    v[j] = xv + g2 * y;
                }
                if (l + 1 < DEPTH) {
#pragma unroll
                    for (int j = 0; j < 4; ++j) xr[64 * j] = v[j];
                    const float* mn = mod + ((size_t)(l + 1) * BATCH + b) * 6 * D;
                    norm_mod(v, norm1_g + (l + 1) * D, mn, mn + D, lane, 1e-6f);
                    store_row_bf16(XN + (size_t)m * D, v, lane);
                } else {
                    norm_mod(v, args.in[22], nullptr, nullptr, lane, 1e-6f);
#pragma unroll
                    for (int j = 0; j < 4; ++j) xr[64 * j] = v[j];
                }
            }
            if (BOTH(pb + 7)) GRID_BAR();
        }
    }
#undef IN
#undef BOTH
}

extern "C" void kernel_launch(void* const* d_in, const int* in_sizes, int n_in, void* d_out, int out_size, void* d_ws, size_t ws_size, hipStream_t stream) {
    static int grid = 0;
    if (grid == 0) {
        if (n_in != 23 || out_size != NTOK * D || ws_size < WS_END) { fprintf(stderr, "kernel_launch: unexpected shapes (n_in %d out %d ws %zu)\n", n_in, out_size, ws_size); grid = -1; return; }
        int dev = 0, cus = 0, per_cu = 0;
        if (hipGetDevice(&dev) != hipSuccess || hipDeviceGetAttribute(&cus, hipDeviceAttributeMultiprocessorCount, dev) != hipSuccess) { grid = -1; return; }
        if (hipFuncSetAttribute((const void*)fwd, hipFuncAttributeMaxDynamicSharedMemorySize, LDS_BYTES) != hipSuccess) { fprintf(stderr, "kernel_launch: hipFuncSetAttribute failed\n"); grid = -1; return; }
        if (hipOccupancyMaxActiveBlocksPerMultiprocessor(&per_cu, (const void*)fwd, NTHR, LDS_BYTES) != hipSuccess || per_cu < 1) fprintf(stderr, "kernel_launch: occupancy query reports %d\n", per_cu);
        (void)hipGetLastError();
        grid = cus;
        if (grid != 256) { fprintf(stderr, "kernel_launch: built for 256 CUs, found %d\n", cus); grid = -1; return; }
    }
    if (grid < 0) return;
    (void)in_sizes;
    if (hipMemsetAsync((char*)d_ws + WS_CTL, 0, CTL_ZERO_BYTES, stream) != hipSuccess) return;
    Args a{};
    for (int i = 0; i < 23; ++i) a.in[i] = (const float*)d_in[i];
    a.out = (float*)d_out; a.ws = (unsigned char*)d_ws;
#if MK_ONE_LAUNCH
    a.ph_lo = 0; a.ph_hi = NPHASE;
    hipLaunchKernelGGL(fwd, dim3(grid), dim3(NTHR), LDS_BYTES, stream, a);
#else
    for (int p = 0; p < NPHASE; ++p) { a.ph_lo = p; a.ph_hi = p + 1; hipLaunchKernelGGL(fwd, dim3(grid), dim3(NTHR), LDS_BYTES, stream, a); }
#endif
}
```

```cpp
#include <hip/hip_runtime.h>
#include <cstdio>
#include <cstdint>
#include <cmath>

#ifndef MK_ONE_LAUNCH
#define MK_ONE_LAUNCH 1
#endif

namespace pg8 {
#define PG8_LAS __attribute__((address_space(3)))
typedef unsigned short bf16_t;
typedef short bf16x8 __attribute__((ext_vector_type(8)));
typedef float f32x4 __attribute__((ext_vector_type(4)));
typedef unsigned u32x4 __attribute__((ext_vector_type(4)));
constexpr int BM = 256, BK = 64, HALF = 128, HTB = HALF * BK * 2, NXCD = 8, WGM = 8;

__host__ __device__ __forceinline__ int lds_byte(int r, int c) { const int st = (r >> 4) * 2 + (c >> 5), rr = r & 15, cc = c & 31, ob = rr * 64 + cc * 2; return st * 1024 + (ob ^ (((ob >> 9) & 1) << 5)); }
__host__ __device__ __forceinline__ void stage_rc(int b, int& R, int& C) { const int st = b / 1024, sb = b % 1024, swz = sb ^ (((sb >> 9) & 1) << 5); R = (st >> 1) * 16 + swz / 64; C = (st & 1) * 32 + (swz % 64) / 2; }
__host__ __device__ __forceinline__ int perm32(int rho) { const int n = rho >> 4, i = rho & 15; return 8 * (i >> 2) + 4 * n + (i & 3); }

struct Unit { int pm, pn; const bf16_t* Bt; };

struct StaticOrder {
    int nM, nN, nwg, G, c; const bf16_t* Bt;
    __device__ void init(int M, int N, int G_, int c_, const bf16_t* Bt_) { nM = M / BM; nN = N / BM; nwg = nM * nN; G = G_; c = c_; Bt = Bt_; }
    __device__ bool next(int i, Unit& u) const {
        const long L = (long)i * G + c; if (L >= nwg) return false;
        int wgid = (int)L; { const int q = nwg / NXCD, r = nwg % NXCD, xcd = wgid % NXCD, off = wgid / NXCD; wgid = (xcd < r ? xcd * (q + 1) : r * (q + 1) + (xcd - r) * q) + off; }
        const int nig = WGM * nN, gid = wgid / nig, fm = gid * WGM, gsz = (nM - fm) < WGM ? (nM - fm) : WGM;
        u.pm = fm + ((wgid % nig) % gsz); u.pn = (wgid % nig) / gsz; u.Bt = Bt; return true;
    }
};
struct GroupedOrder {
    const PG8_LAS int* tl; int G, c; const bf16_t* Bt; size_t estride;
    __device__ bool next(int i, Unit& u) const {
        const int L = i * G + c; const int nt = tl[0]; if (L >= nt * 4) return false;
        u.pm = L >> 2; u.pn = L & 3; u.Bt = Bt + (size_t)tl[1 + (L >> 2)] * estride; return true;
    }
};

__device__ __forceinline__ unsigned cvt_pk_bf16(float lo, float hi) { unsigned r; asm volatile("v_cvt_pk_bf16_f32 %0, %1, %2" : "=v"(r) : "v"(lo), "v"(hi)); return r; }

struct EpiBf16 {
    static constexpr bool PERM = true;
    bf16_t* O; int ldc; int split_cols; size_t split_stride; float scale0;
    __device__ __forceinline__ void operator()(const f32x4 (&acc)[2][2][4][2], const Unit& u, int wr, int wc, int fr, int fq) const {
        const int row0 = u.pm * BM + wr * 64 + fr; int colt = u.pn * BM; bf16_t* base = O;
        float sc = 1.f; if (split_cols) { const int t = colt / split_cols; base += (size_t)t * split_stride; colt -= t * split_cols; if (t == 0) sc = scale0; }
        const int col0 = colt + wc * 32 + 8 * fq;
#pragma unroll
        for (int ai = 0; ai < 2; ++ai)
#pragma unroll
            for (int m = 0; m < 4; ++m) { bf16_t* rowp = base + (size_t)(row0 + ai * HALF + m * 16) * ldc + col0;
#pragma unroll
                for (int bj = 0; bj < 2; ++bj) { const f32x4 v0 = acc[ai][bj][m][0] * sc, v1 = acc[ai][bj][m][1] * sc;
                    u32x4 w; w.x = cvt_pk_bf16(v0[0], v0[1]); w.y = cvt_pk_bf16(v0[2], v0[3]); w.z = cvt_pk_bf16(v1[0], v1[1]); w.w = cvt_pk_bf16(v1[2], v1[3]);
                    *(u32x4*)(rowp + bj * HALF) = w; } }
    }
};
struct EpiResid {
    static constexpr bool PERM = false;
    float* C; const float* X; int ldc; const float* gate; int gstride; int rows_per_batch;
    __device__ __forceinline__ void operator()(const f32x4 (&acc)[2][2][4][2], const Unit& u, int wr, int wc, int fr, int fq) const {
        const int row0 = u.pm * BM + wr * 64 + fr, col0 = u.pn * BM + wc * 32 + 4 * fq;
        const float* gp = gate + (size_t)((u.pm * BM) / rows_per_batch) * gstride + col0;
        f32x4 gv[2][2];
#pragma unroll
        for (int bj = 0; bj < 2; ++bj)
#pragma unroll
            for (int n = 0; n < 2; ++n) gv[bj][n] = *(const f32x4*)(gp + bj * HALF + n * 16);
#pragma unroll
        for (int ai = 0; ai < 2; ++ai)
#pragma unroll
            for (int m = 0; m < 4; ++m) { const size_t ro = (size_t)(row0 + ai * HALF + m * 16) * ldc + col0;
#pragma unroll
                for (int bj = 0; bj < 2; ++bj)
#pragma unroll
                    for (int n = 0; n < 2; ++n) { const f32x4 xv = *(const f32x4*)(X + ro + bj * HALF + n * 16); *(f32x4*)(C + ro + bj * HALF + n * 16) = xv + gv[bj][n] * acc[ai][bj][m][n]; } }
    }
};
struct EpiSwiGLU {
    static constexpr bool PERM = true;
    bf16_t* H; int ldh;
    __device__ __forceinline__ void operator()(const f32x4 (&acc)[2][2][4][2], const Unit& u, int wr, int wc, int fr, int fq) const {
        const int row0 = u.pm * BM + wr * 64 + fr, col0 = u.pn * HALF + wc * 32 + 8 * fq;
#pragma unroll
        for (int ai = 0; ai < 2; ++ai)
#pragma unroll
            for (int m = 0; m < 4; ++m) { bf16_t* rowp = H + (size_t)(row0 + ai * HALF + m * 16) * ldh + col0;
                float hv[8];
#pragma unroll
                for (int n = 0; n < 2; ++n)
#pragma unroll
                    for (int j = 0; j < 4; ++j) { const float g = acc[ai][0][m][n][j], uu = acc[ai][1][m][n][j]; hv[n * 4 + j] = g * __builtin_amdgcn_rcpf(1.f + __builtin_amdgcn_exp2f(-1.4426950408889634f * g)) * uu; }
                u32x4 w; w.x = cvt_pk_bf16(hv[0], hv[1]); w.y = cvt_pk_bf16(hv[2], hv[3]); w.z = cvt_pk_bf16(hv[4], hv[5]); w.w = cvt_pk_bf16(hv[6], hv[7]);
                *(u32x4*)rowp = w; }
    }
};

template <class Epi, class Sched, bool GATHER>
__device__ __forceinline__ void gemm_phase(PG8_LAS unsigned char* lds, const bf16_t* Ab_, const int K, const PG8_LAS int* gidx, const Sched& S, const Epi& E) {
    int tid_ = threadIdx.x; asm volatile("" : "+v"(tid_));
    const int tid = tid_, wid = __builtin_amdgcn_readfirstlane(tid >> 6), lane = tid & 63, wr = wid >> 2, wc = wid & 3, fr = lane & 15, fq = lane >> 4;
    const int nt = K / BK;
    const char* Ab = (const char*)Ab_;
    int RA[2]; unsigned CA2[2], voffB[2];
#pragma unroll
    for (int i = 0; i < 2; ++i) { int R, C; stage_rc(tid * 16 + i * 8192, R, C); const int Rb = Epi::PERM ? ((R & ~31) + perm32(R & 31)) : R;
        RA[i] = R; CA2[i] = (unsigned)C * 2u; voffB[i] = (unsigned)(Rb * K + C) * 2u; }
    const unsigned rowbytes = (unsigned)K * 2u;
    const unsigned kstep = (unsigned)(BK * 2);
    const size_t hstep = (size_t)HALF * K * 2;
    const size_t tstep = 2 * hstep;
    const unsigned ldsw = (unsigned)wid * 1024u;
    const int aoff = lds_byte(wr * 64 + fr, fq * 8), boff = lds_byte(wc * 32 + fr, fq * 8);
#define PG8_SA(b, h) (((b) * 2 + (h)) * HTB)
#define PG8_SB(b, h) ((4 + (b) * 2 + (h)) * HTB)
#define PG8_STAGEB(bufoff, gbase) do { _Pragma("unroll") for (int _i = 0; _i < 2; ++_i) \
        __builtin_amdgcn_global_load_lds((const unsigned*)((const char*)(gbase) + voffB[_i]), (PG8_LAS unsigned*)(lds + (bufoff) + ldsw + _i * 8192), 16, 0, 0); } while (0)
#define PG8_STAGEA(bufoff, o0, o1) do { \
        __builtin_amdgcn_global_load_lds((const unsigned*)(Ab + (o0)), (PG8_LAS unsigned*)(lds + (bufoff) + ldsw), 16, 0, 0); \
        __builtin_amdgcn_global_load_lds((const unsigned*)(Ab + (o1)), (PG8_LAS unsigned*)(lds + (bufoff) + ldsw + 8192), 16, 0, 0); } while (0)
#define PG8_LDA(dst, b, h) do { _Pragma("unroll") for (int m = 0; m < 4; ++m) _Pragma("unroll") for (int k = 0; k < 2; ++k) dst[m][k] = *(const PG8_LAS bf16x8*)(lds + PG8_SA(b, h) + aoff + m * 2048 + k * 1024); } while (0)
#define PG8_LDB(dst, b, h) do { _Pragma("unroll") for (int n = 0; n < 2; ++n) _Pragma("unroll") for (int k = 0; k < 2; ++k) dst[n][k] = *(const PG8_LAS bf16x8*)(lds + PG8_SB(b, h) + boff + n * 2048 + k * 1024); } while (0)
#define PG8_MMA(ai, bj, At, Bt) do { __builtin_amdgcn_s_setprio(1); _Pragma("unroll") for (int m = 0; m < 4; ++m) _Pragma("unroll") for (int n = 0; n < 2; ++n) _Pragma("unroll") for (int k = 0; k < 2; ++k) \
        acc[ai][bj][m][n] = __builtin_amdgcn_mfma_f32_16x16x32_bf16(Bt[n][k], At[m][k], acc[ai][bj][m][n], 0, 0, 0); __builtin_amdgcn_s_setprio(0); } while (0)
#define PG8_WAIT_V(n) asm volatile("s_waitcnt vmcnt(" #n ")" ::: "memory")
#define PG8_WAIT_L(n) asm volatile("s_waitcnt lgkmcnt(" #n ")" ::: "memory")
#define PG8_BAR __builtin_amdgcn_s_barrier()
#define PG8_SCHED __builtin_amdgcn_sched_barrier(0)
#define PG8_MKOFF(dst, u, ui_) do { _Pragma("unroll") for (int h = 0; h < 2; ++h) _Pragma("unroll") for (int i = 0; i < 2; ++i) { \
        int row_ = (u).pm * BM + h * HALF + RA[i]; if (GATHER) row_ = gidx[(ui_) * BM + h * HALF + RA[i]]; dst[h][i] = (unsigned)row_ * rowbytes + CA2[i]; } } while (0)
    Unit cur, nxt; int ui = 0;
    if (!S.next(0, cur)) return;
    f32x4 acc[2][2][4][2];
#pragma unroll
    for (int a = 0; a < 2; ++a)
#pragma unroll
        for (int b = 0; b < 2; ++b)
#pragma unroll
            for (int m = 0; m < 4; ++m)
#pragma unroll
                for (int n = 0; n < 2; ++n) acc[a][b][m][n] = (f32x4){0.f, 0.f, 0.f, 0.f};
    bf16x8 At[4][2], B0[2][2], B1[2][2];
    unsigned curo[2][2], nxto[2][2];
    PG8_MKOFF(curo, cur, 0);
    const char* cB = (const char*)cur.Bt + (size_t)cur.pn * tstep;
    PG8_STAGEB(PG8_SB(0, 0), cB); PG8_STAGEB(PG8_SB(0, 1), cB + hstep); PG8_STAGEA(PG8_SA(0, 0), curo[0][0], curo[0][1]); PG8_STAGEA(PG8_SA(0, 1), curo[1][0], curo[1][1]);
    if (wr == 1) PG8_BAR;
    PG8_WAIT_V(2); PG8_BAR;
    PG8_STAGEB(PG8_SB(1, 0), cB + kstep); PG8_STAGEA(PG8_SA(1, 0), curo[0][0] + kstep, curo[0][1] + kstep); PG8_STAGEB(PG8_SB(1, 1), cB + hstep + kstep);
    PG8_WAIT_V(6); PG8_BAR;
    for (;;) {
        const bool has_next = S.next(ui + 1, nxt);
        if (has_next) { PG8_MKOFF(nxto, nxt, ui + 1); } else {
#pragma unroll
            for (int h = 0; h < 2; ++h)
#pragma unroll
                for (int i = 0; i < 2; ++i) nxto[h][i] = curo[h][i]; }
        const char* nB = has_next ? (const char*)nxt.Bt + (size_t)nxt.pn * tstep : cB;
        for (int t = 0; t < nt; t += 2) {
            const bool last = (t == nt - 2);
            const unsigned kb1 = (unsigned)(t + 1) * kstep, kb2 = last ? 0u : (unsigned)(t + 2) * kstep, kb3 = kb2 + kstep;
            const unsigned s00 = last ? nxto[0][0] : curo[0][0], s01 = last ? nxto[0][1] : curo[0][1], s10 = last ? nxto[1][0] : curo[1][0], s11 = last ? nxto[1][1] : curo[1][1];
            const char* b2 = last ? nB : cB + (size_t)(t + 2) * kstep; const char* b3 = b2 + kstep;
            PG8_LDB(B0, 0, 0); PG8_LDB(B1, 0, 1); PG8_SCHED; PG8_LDA(At, 0, 0); PG8_STAGEA(PG8_SA(1, 1), curo[1][0] + kb1, curo[1][1] + kb1);
            PG8_WAIT_V(8); PG8_WAIT_L(0); PG8_BAR; PG8_MMA(0, 0, At, B0); PG8_MMA(0, 1, At, B1); PG8_BAR; PG8_SCHED;
            PG8_LDA(At, 0, 1); PG8_STAGEB(PG8_SB(0, 0), b2); PG8_STAGEB(PG8_SB(0, 1), b2 + hstep); PG8_STAGEA(PG8_SA(0, 0), s00 + kb2, s01 + kb2);
            PG8_WAIT_V(8); PG8_WAIT_L(0); PG8_BAR; PG8_MMA(1, 0, At, B0); PG8_MMA(1, 1, At, B1); PG8_BAR; PG8_SCHED;
            PG8_LDB(B0, 1, 0); PG8_LDB(B1, 1, 1); PG8_SCHED; PG8_LDA(At, 1, 0); PG8_STAGEA(PG8_SA(0, 1), s10 + kb2, s11 + kb2);
            PG8_WAIT_V(8); PG8_WAIT_L(0); PG8_BAR; PG8_MMA(0, 0, At, B0); PG8_MMA(0, 1, At, B1); PG8_BAR; PG8_SCHED;
            PG8_LDA(At, 1, 1); PG8_STAGEB(PG8_SB(1, 0), b3); PG8_STAGEB(PG8_SB(1, 1), b3 + hstep); PG8_STAGEA(PG8_SA(1, 0), s00 + kb3, s01 + kb3);
            PG8_WAIT_V(8); PG8_WAIT_L(0); PG8_BAR; PG8_MMA(1, 0, At, B0); PG8_MMA(1, 1, At, B1); PG8_BAR; PG8_SCHED;
        }
        if (wr == 0) PG8_BAR;
        E(acc, cur, wr, wc, fr, fq);
        if (!has_next) break;
#pragma unroll
        for (int a = 0; a < 2; ++a)
#pragma unroll
            for (int b = 0; b < 2; ++b)
#pragma unroll
                for (int m = 0; m < 4; ++m)
#pragma unroll
                    for (int n = 0; n < 2; ++n) acc[a][b][m][n] = (f32x4){0.f, 0.f, 0.f, 0.f};
        cur = nxt; cB = nB; ++ui;
#pragma unroll
        for (int h = 0; h < 2; ++h)
#pragma unroll
            for (int i = 0; i < 2; ++i) curo[h][i] = nxto[h][i];
        if (wr == 1) PG8_BAR;
    }
    PG8_WAIT_V(0);
    PG8_BAR;
#undef PG8_SA
#undef PG8_SB
#undef PG8_STAGEA
#undef PG8_STAGEB
#undef PG8_LDA
#undef PG8_LDB
#undef PG8_MMA
#undef PG8_WAIT_V
#undef PG8_WAIT_L
#undef PG8_BAR
#undef PG8_SCHED
#undef PG8_MKOFF
}
}

constexpr int NWAVES = 8, NTHR = NWAVES * 64;
constexpr int D = 1024, BATCH = 8, SEQ = 2048, NTOK = BATCH * SEQ, DEPTH = 2;
constexpr int NG = 4, EPG = 8, NE = 32, FH = 512, NPAIR = NTOK * 2;
constexpr int MAX_SLOTS = NPAIR + NE * 256;
constexpr int MAX_TILES = MAX_SLOTS / 256;
constexpr int NPHASE = 2 + 8 * DEPTH;
constexpr float C2 = 0.125f * 1.4426950408889634f;
constexpr float LOG2E = 1.4426950408889634f, LN2 = 0.6931471805599453f;

constexpr size_t MiB = 1u << 20;
constexpr size_t WS_CTL = 0, CTL_ZERO_BYTES = 1 * MiB;
constexpr size_t WS_MOD = 1 * MiB;
constexpr size_t WS_EID = 2 * MiB, WS_EW = 3 * MiB, WS_HIST = 4 * MiB, WS_SOP = 5 * MiB, WS_STOK = 6 * MiB, WS_TILES = 7 * MiB;
constexpr size_t LSTRIDE = 512 * 1024;
constexpr size_t WS_W = 8 * MiB, W_LAYER = 104 * MiB, W_IN = 0, W_OUT = 6 * MiB, W_GU = 8 * MiB, W_DN = 72 * MiB;
constexpr size_t WS_XN = 216 * MiB;
constexpr size_t WS_Q = 248 * MiB, WS_K = 280 * MiB, WS_V = 312 * MiB, WS_O = 344 * MiB;
constexpr size_t WS_HM = 248 * MiB;
constexpr size_t WS_YD = 288 * MiB;
constexpr size_t WS_END = 376 * MiB;
constexpr int CW_BAR = 4096;
constexpr int RING_BYTES = 131072, AUX_OFF = 131072, MISC_OFF = 147456, LDS_BYTES = 163840;

#define GAS __attribute__((address_space(1)))
#define LAS __attribute__((address_space(3)))
typedef unsigned short bf16;
typedef unsigned v4u __attribute__((ext_vector_type(4)));
typedef unsigned v2u __attribute__((ext_vector_type(2)));
typedef float f32x4 __attribute__((ext_vector_type(4)));
typedef GAS unsigned gu32;
#define RLX_AGENT __ATOMIC_RELAXED, __HIP_MEMORY_SCOPE_AGENT
#define LDS_WAIT() asm volatile("s_waitcnt lgkmcnt(0)" ::: "memory")
__device__ __forceinline__ unsigned f2bf(float f) { unsigned u = __builtin_bit_cast(unsigned, f); return (u + 0x7fffu + ((u >> 16) & 1u)) >> 16; }
__device__ __forceinline__ unsigned pk2(float lo, float hi) { return f2bf(lo) | (f2bf(hi) << 16); }
__device__ __forceinline__ float bf_lo(unsigned w) { return __builtin_bit_cast(float, w << 16); }
__device__ __forceinline__ float bf_hi(unsigned w) { return __builtin_bit_cast(float, w & 0xffff0000u); }
__device__ __forceinline__ int vzero() { int z = 0; asm volatile("" : "+v"(z)); return z; }

#define XB_TMO      128
#define XB_XCNT(j)  (256  + 64 * (j))
#define XB_XSUB(j)  (1280 + 64 * (j))
#define XB_XGEN(j)  (2304 + 64 * (j))
#define XB_TOP      3328
#define XB_TOPGEN   3392
#define XCD_BAR_WORDS 3456
#define XB_SPIN_CAP (1u << 18)
__device__ __forceinline__ unsigned xb_ld(unsigned* p)              { return __hip_atomic_load(p, __ATOMIC_RELAXED, __HIP_MEMORY_SCOPE_AGENT); }
__device__ __forceinline__ unsigned xb_add(unsigned* p, unsigned v) { return __hip_atomic_fetch_add(p, v, __ATOMIC_RELAXED, __HIP_MEMORY_SCOPE_AGENT); }
__device__ __forceinline__ unsigned xb_xcc_id() { return (unsigned)__builtin_amdgcn_s_getreg((3 << 11) | 20) & 0xFu; }
#define XB_SPIN(cond, bar) do { unsigned _sp = 0; while (cond) { __builtin_amdgcn_s_sleep(1); \
    if ((++_sp & 255u) == 0u) { if (xb_ld(&(bar)[XB_TMO])) break; if (_sp > XB_SPIN_CAP) { atomicAdd(&(bar)[XB_TMO], 1u); break; } } } } while (0)
struct XcdBarrier { unsigned* bar; unsigned x; volatile LAS unsigned* st; };
__device__ __forceinline__ XcdBarrier xcd_barrier_post(unsigned* bar, volatile LAS unsigned* st) {
    XcdBarrier b; b.bar = bar; b.x = xb_xcc_id(); b.st = st;
    if (threadIdx.x == 0) (void)xb_add(&bar[XB_XCNT(b.x)], 1u);
    return b;
}
__device__ __forceinline__ void xcd_barrier_complete(unsigned* bar, unsigned x, unsigned& nloc, unsigned& nx) {
    const unsigned G = gridDim.x * gridDim.y * gridDim.z;
    unsigned sum, cnt, mine, sp = 0u;
    for (;;) {
        sum = 0u; cnt = 0u; mine = 0u;
#pragma unroll
        for (unsigned j = 0; j < 16; ++j) { const unsigned c = xb_ld(&bar[XB_XCNT(j)]); sum += c; cnt += (c > 0u) ? 1u : 0u; mine = (j == x) ? c : mine; }
        if (sum == G) break;
        __builtin_amdgcn_s_sleep(1);
        if ((++sp & 255u) == 0u) { if (xb_ld(&bar[XB_TMO])) break; if (sp > XB_SPIN_CAP) { atomicAdd(&bar[XB_TMO], 1u); break; } }
    }
    nloc = mine > 0u ? mine : 1u; nx = cnt > 0u ? cnt : 1u;
}
__device__ __forceinline__ void xcd_barrier(const XcdBarrier& b) {
    asm volatile("s_waitcnt vmcnt(0)" ::: "memory");
    __syncthreads();
    if (threadIdx.x == 0) {
        unsigned* bar = b.bar;
        __builtin_amdgcn_s_waitcnt(0);
        unsigned nloc = b.st[0], nx = b.st[1];
        if (nloc == 0u) { xcd_barrier_complete(bar, b.x, nloc, nx); b.st[0] = nloc; b.st[1] = nx; }
        const unsigned old = xb_add(&bar[XB_XSUB(b.x)], 1u);
        const unsigned gen = old / nloc;
        if (old + 1u == (gen + 1u) * nloc) {
            __builtin_amdgcn_fence(__ATOMIC_RELEASE, "agent");
            asm volatile("s_waitcnt vmcnt(0)" ::: "memory");
            const unsigned og = xb_add(&bar[XB_TOP], 1u);
            const unsigned tg = og / nx;
            if (og + 1u == (tg + 1u) * nx) xb_add(&bar[XB_TOPGEN], 1u);
            else XB_SPIN(xb_ld(&bar[XB_TOPGEN]) == tg, bar);
            __builtin_amdgcn_fence(__ATOMIC_ACQUIRE, "agent");
            xb_add(&bar[XB_XGEN(b.x)], 1u);
            asm volatile("s_waitcnt vmcnt(0)" ::: "memory");
        } else {
            XB_SPIN(xb_ld(&bar[XB_XGEN(b.x)]) == gen, bar);
            __builtin_amdgcn_fence(__ATOMIC_ACQUIRE, "agent");
            asm volatile("s_waitcnt vmcnt(0)" ::: "memory");
        }
    }
    __syncthreads();
}

__device__ __forceinline__ float wave_sum(float v) {
#pragma unroll
    for (int o = 1; o < 64; o <<= 1) v += __shfl_xor(v, o);
    return v;
}
__device__ __forceinline__ float wave_max(float v) {
#pragma unroll
    for (int o = 1; o < 64; o <<= 1) v = fmaxf(v, __shfl_xor(v, o));
    return v;
}
__device__ __forceinline__ void transpose_item(const float* W, int K, int N, bf16* WT, int drow, LAS float* scr, int k0, int n0, int lane) {
#pragma unroll 8
    for (int i = 0; i < 32; ++i) { const int kk = 2 * i + (lane >> 5); scr[kk * 33 + (lane & 31)] = W[(size_t)(k0 + kk) * N + n0 + (lane & 31)]; }
    LDS_WAIT(); asm volatile("" ::: "memory");
    const int c = lane & 7;
#pragma unroll
    for (int j = 0; j < 4; ++j) { const int n = (lane >> 3) + 8 * j; const LAS float* s = scr + (8 * c) * 33 + n;
        v4u o; o.x = pk2(s[0 * 33], s[1 * 33]); o.y = pk2(s[2 * 33], s[3 * 33]); o.z = pk2(s[4 * 33], s[5 * 33]); o.w = pk2(s[6 * 33], s[7 * 33]);
        *(GAS v4u*)(WT + (size_t)(drow + n) * K + k0 + 8 * c) = o; }
    LDS_WAIT(); asm volatile("" ::: "memory");
}
__device__ __forceinline__ void norm_mod(f32x4 (&v)[4], const float* g, const float* sh, const float* sc, int lane, float eps) {
    float ss = 0.f;
#pragma unroll
    for (int j = 0; j < 4; ++j) ss += (v[j].x * v[j].x + v[j].y * v[j].y) + (v[j].z * v[j].z + v[j].w * v[j].w);
    const float r = 1.0f / sqrtf(wave_sum(ss) * (1.f / D) + eps);
#pragma unroll
    for (int j = 0; j < 4; ++j) {
        const int c0 = 4 * lane + 256 * j;
        const f32x4 gg = *(const f32x4*)(g + c0);
        v[j] = v[j] * r * gg;
        if (sc) { const f32x4 s1 = *(const f32x4*)(sc + c0), s0 = *(const f32x4*)(sh + c0); v[j] = v[j] * (1.f + s1) + s0; }
    }
}
__device__ __forceinline__ void store_row_bf16(bf16* orow, const f32x4 (&v)[4], int lane) {
    GAS unsigned long long* o8 = (GAS unsigned long long*)orow + lane;
#pragma unroll
    for (int j = 0; j < 4; ++j) o8[64 * j] = (unsigned long long)pk2(v[j].x, v[j].y) | ((unsigned long long)pk2(v[j].z, v[j].w) << 32);
}
__device__ __forceinline__ float dot8(const v4u kv, const LAS float* q) {
    return bf_lo(kv.x) * q[0] + bf_hi(kv.x) * q[1] + bf_lo(kv.y) * q[2] + bf_hi(kv.y) * q[3] + bf_lo(kv.z) * q[4] + bf_hi(kv.z) * q[5] + bf_lo(kv.w) * q[6] + bf_hi(kv.w) * q[7];
}


namespace att {
typedef short bf16x8 __attribute__((ext_vector_type(8)));
typedef short s16x4 __attribute__((ext_vector_type(4)));
typedef short v4i16_t __attribute__((ext_vector_type(4)));
typedef float f32x16 __attribute__((ext_vector_type(16)));
typedef unsigned u32x4 __attribute__((ext_vector_type(4)));
typedef float f32x2_t __attribute__((ext_vector_type(2))); typedef __bf16 bf16x2_t __attribute__((ext_vector_type(2)));
typedef LAS const unsigned char* lds_cptr;
__device__ __forceinline__ int crow(int r, int hi) { return (r & 3) + 8 * (r >> 2) + 4 * hi; }
__device__ __forceinline__ int kperm(int i) { return 16 * ((i >> 2) & 1) + (i & 3) + 4 * (i >> 3); }
__device__ __forceinline__ void glds16(const void* gsrc, unsigned lds_dst) { unsigned keep;
    asm volatile("s_mov_b32 %0, m0\n\ts_mov_b32 m0, %2\n\ts_nop 0\n\tglobal_load_lds_dwordx4 %1, off\n\ts_mov_b32 m0, %0" : "=&s"(keep) : "v"(gsrc), "s"(lds_dst) : "memory"); }
__device__ __forceinline__ unsigned cvtpk_s(float lo, float hi) { f32x2_t v = {lo, hi}; bf16x2_t b = __builtin_convertvector(v, bf16x2_t); return __builtin_bit_cast(unsigned, b); }
__device__ __forceinline__ s16x4 vtr(lds_cptr p) { return __builtin_bit_cast(s16x4, __builtin_amdgcn_ds_read_tr16_b64_v4i16((LAS v4i16_t*)p)); }
__device__ __forceinline__ float partner(float v, int hi) { auto rr = __builtin_amdgcn_permlane32_swap(__float_as_uint(v), __float_as_uint(v), false, false); return __uint_as_float(hi ? rr[0] : rr[1]); }
#define ATT_WAIT_BAR(N) asm volatile("s_waitcnt vmcnt(" #N ") lgkmcnt(0)\n\ts_barrier" ::: "memory")
#define ATT_PACK(P, B) (u32x4){cvtpk_s(P[B], P[B + 1]), cvtpk_s(P[B + 2], P[B + 3]), cvtpk_s(P[B + 4], P[B + 5]), cvtpk_s(P[B + 6], P[B + 7])}

__device__ __forceinline__ void diff_unit(int b, int h, int qb, const bf16* Q, const bf16* K, const bf16* V, bf16* O, LAS unsigned char* shm, float lam, const float* subg, int tid) {
    const int lane = tid & 63, r32 = lane & 31, hi = lane >> 5; const int wid = __builtin_amdgcn_readfirstlane(tid >> 6);
    const int m = wid >> 2, rg = wid & 3;
    const long rowbase = (long)b * SEQ; const int q0 = qb * 128;
    const float slope2 = __builtin_amdgcn_exp2f(-(float)(h + 1)) * LOG2E;
    const unsigned lds0 = (unsigned)(uintptr_t)shm;
    LAS float* wsf = (LAS float*)(shm + 65536 + wid * 256);
    const bf16* dsrc; long dstep; unsigned ddst;
    if (wid < 4) { const int key = 32 * (lane >> 5) + kperm(lane & 31); dsrc = K + (rowbase + key) * D + h * 128 + (wid >> 1) * 64 + 32 * (wid & 1); dstep = 8; ddst = ((wid >> 1) * 8 + 4 * (wid & 1)) * 1024; }
    else { dsrc = V + (rowbase + (lane >> 2)) * D + h * 128 + (wid - 4) * 32 + (lane & 3) * 8; dstep = 16 * D; ddst = 16384 + (wid - 4) * 4096; }
#define DIFF_DMA(j, slot) do { const unsigned d_ = (unsigned)__builtin_amdgcn_readfirstlane(lds0 + (slot) * 32768 + ddst); const bf16* s_ = dsrc + (long)(j) * 64 * D; \
        glds16(s_, d_); glds16(s_ + dstep, d_ + 1024); glds16(s_ + 2 * dstep, d_ + 2048); glds16(s_ + 3 * dstep, d_ + 3072); } while (0)
    const int nt = 2 * qb + 2, jw = 2 * qb + (rg >> 1);
    DIFF_DMA(0, 0);
    bf16x8 qr[4];
    { const bf16* Qw = Q + (rowbase + q0 + 32 * rg) * D + h * 128 + m * 64;
#pragma unroll
      for (int d0 = 0; d0 < 4; ++d0) qr[d0] = *reinterpret_cast<const bf16x8*>(&Qw[(long)r32 * D + d0 * 16 + hi * 8]); }
    float mhat = 0.f, l_reg = 0.f; f32x16 o[4];
#pragma unroll
    for (int e = 0; e < 4; ++e) o[e] = f32x16{};
    const float tqf = (float)(q0 + 32 * rg + r32);
    const lds_cptr kp0 = (lds_cptr)shm + m * 8192 + hi * 1024 + r32 * 16;
    const lds_cptr vp0 = (lds_cptr)shm + 16384 + hi * 1024 + ((lane & 15) >> 2) * 64 + ((lane >> 4) & 1) * 32 + (lane & 3) * 8;
    for (int j = 0; j < nt; ++j) {
        const int slot = j & 1;
        ATT_WAIT_BAR(0);
        if (j + 1 < nt) DIFF_DMA(j + 1, slot ^ 1);
        if (j <= jw) {
            f32x16 p0, p1;
            { const float base0 = (float)(64 * j + 16 * hi) - tqf;
#pragma unroll
              for (int r = 0; r < 16; ++r) { const float d0 = base0 + (float)r; p0[r] = __builtin_fmaf(-slope2, __builtin_fabsf(d0), -mhat); p1[r] = __builtin_fmaf(-slope2, __builtin_fabsf(d0 + 32.f), -mhat); } }
            const lds_cptr kp = kp0 + slot * 32768;
#pragma unroll
            for (int d0 = 0; d0 < 4; ++d0) {
                const bf16x8 k0 = *(const LAS bf16x8*)(kp + d0 * 2048), k1 = *(const LAS bf16x8*)(kp + d0 * 2048 + 512);
                p0 = __builtin_amdgcn_mfma_f32_32x32x16_bf16(k0, qr[d0], p0, 0, 0, 0); p1 = __builtin_amdgcn_mfma_f32_32x32x16_bf16(k1, qr[d0], p1, 0, 0, 0);
            }
            float rm = __builtin_fmaxf(p0[0], p1[0]);
#pragma unroll
            for (int r = 1; r < 16; ++r) rm = __builtin_fmaxf(rm, __builtin_fmaxf(p0[r], p1[r]));
            rm = __builtin_fmaxf(rm, partner(rm, hi));
            if (j == 0) { mhat = rm;
#pragma unroll
                for (int r = 0; r < 16; ++r) { p0[r] -= rm; p1[r] -= rm; } }
            else if (__any(rm > 8.f)) {
                const float dl = __builtin_fmaxf(rm, 0.f); mhat += dl;
#pragma unroll
                for (int r = 0; r < 16; ++r) { p0[r] -= dl; p1[r] -= dl; }
                const float f = __builtin_amdgcn_exp2f(-dl); l_reg *= f; if (hi == 0) wsf[r32] = f;
                asm volatile("s_waitcnt lgkmcnt(0)" ::: "memory");
#pragma unroll
                for (int e = 0; e < 4; ++e)
#pragma unroll
                    for (int r = 0; r < 16; ++r) o[e][r] *= wsf[crow(r, hi)];
            }
            float sacc = 0.f;
#pragma unroll
            for (int r = 0; r < 16; ++r) { p0[r] = __builtin_amdgcn_exp2f(p0[r]); p1[r] = __builtin_amdgcn_exp2f(p1[r]); sacc += p0[r] + p1[r]; }
            l_reg += sacc;
            const u32x4 pw0 = ATT_PACK(p0, 0), pw1 = ATT_PACK(p0, 8), pw2 = ATT_PACK(p1, 0), pw3 = ATT_PACK(p1, 8);
            const lds_cptr vp = vp0 + slot * 32768;
#pragma unroll
            for (int e = 0; e < 4; ++e) {
#define DIFF_PV(ks, PW) do { const s16x4 lo_ = vtr(vp + e * 4096 + ((ks) >> 1) * 2048 + ((ks) & 1) * 512), hi_ = vtr(vp + e * 4096 + ((ks) >> 1) * 2048 + ((ks) & 1) * 512 + 256); \
                const bf16x8 vb_ = (bf16x8){lo_[0], lo_[1], lo_[2], lo_[3], hi_[0], hi_[1], hi_[2], hi_[3]}; \
                o[e] = __builtin_amdgcn_mfma_f32_32x32x16_bf16(__builtin_bit_cast(bf16x8, PW), vb_, o[e], 0, 0, 0); } while (0)
                DIFF_PV(0, pw0); DIFF_PV(1, pw1); DIFF_PV(2, pw2); DIFF_PV(3, pw3);
#undef DIFF_PV
            }
        }
    }
    l_reg += partner(l_reg, hi);
    { const float rl = (m == 1 ? lam : 1.f) / l_reg; if (hi == 0) wsf[32 + r32] = rl; }
    asm volatile("s_waitcnt lgkmcnt(0)" ::: "memory");
    float rli[16];
#pragma unroll
    for (int r = 0; r < 16; ++r) rli[r] = wsf[32 + crow(r, hi)];
    ATT_WAIT_BAR(0);
    LAS float* S = (LAS float*)(shm + rg * 16384);
    if (m == 1) {
#pragma unroll
        for (int e = 0; e < 4; ++e)
#pragma unroll
            for (int r = 0; r < 16; ++r) S[crow(r, hi) * 128 + e * 32 + r32] = o[e][r] * rli[r];
    }
    ATT_WAIT_BAR(0);
    if (m == 0) {
#pragma unroll
        for (int e = 0; e < 4; ++e)
#pragma unroll
            for (int r = 0; r < 16; ++r) { const int ix = crow(r, hi) * 128 + e * 32 + r32; S[ix] = o[e][r] * rli[r] - S[ix]; }
    }
    ATT_WAIT_BAR(0);
    { const int row = 16 * m + (lane >> 2), qq = lane & 3;
      const LAS f32x4* sp = (const LAS f32x4*)(S + row * 128 + qq * 32);
      f32x4 v[8]; float ss = 0.f;
#pragma unroll
      for (int i = 0; i < 8; ++i) { v[i] = sp[i]; ss += (v[i].x * v[i].x + v[i].y * v[i].y) + (v[i].z * v[i].z + v[i].w * v[i].w); }
      ss += __shfl_xor(ss, 1); ss += __shfl_xor(ss, 2);
      const float rn = 0.8f / sqrtf(ss * (1.f / 128.f) + 1e-5f);
      bf16* op = O + (rowbase + q0 + 32 * rg + row) * D + h * 128 + qq * 32;
#pragma unroll
      for (int i = 0; i < 4; ++i) { const f32x4 g0 = *(const f32x4*)(subg + qq * 32 + 8 * i), g1 = *(const f32x4*)(subg + qq * 32 + 8 * i + 4); const f32x4 a = v[2 * i] * rn * g0, c = v[2 * i + 1] * rn * g1;
          *(u32x4*)(op + 8 * i) = (u32x4){cvtpk_s(a.x, a.y), cvtpk_s(a.z, a.w), cvtpk_s(c.x, c.y), cvtpk_s(c.z, c.w)}; } }
    ATT_WAIT_BAR(0);
#undef DIFF_DMA
}

__device__ __forceinline__ void sb_unit(int b, int h, int qb, const bf16* Q, const bf16* K, const bf16* V, bf16* O, LAS unsigned char* shm, int tid) {
    const int lane = tid & 63, r32 = lane & 31, hi = lane >> 5; const int wid = __builtin_amdgcn_readfirstlane(tid >> 6);
    const long rowbase = (long)b * SEQ; const int q0 = qb * 256;
    const unsigned lds0 = (unsigned)(uintptr_t)shm;
    volatile LAS unsigned* flags = (volatile LAS unsigned*)(shm + 65536);
    const bf16* ksrc = K + (rowbase + 32 * (lane >> 5) + kperm(lane & 31)) * D + h * 64 + wid * 8;
    const bf16* vsrc = V + (rowbase + 16 * (wid & 3) + (lane >> 2)) * D + h * 64 + (wid >> 2) * 32 + (lane & 3) * 8;
    const unsigned kdst = lds0 + wid * 1024, vdst = lds0 + 8192 + wid * 1024;
#define SB_DMA(j, slot) do { glds16(ksrc + (long)(j) * 64 * D, (unsigned)__builtin_amdgcn_readfirstlane(kdst + (slot) * 16384)); glds16(vsrc + (long)(j) * 64 * D, (unsigned)__builtin_amdgcn_readfirstlane(vdst + (slot) * 16384)); } while (0)
    const int jmax = 4 * qb + 3, jw = 4 * qb + (wid >> 1);
    SB_DMA(jmax, 0);
    if (lane == 0) flags[wid] = 0u;
    bf16x8 qr[4];
    { const bf16* Qw = Q + (rowbase + q0 + 32 * wid) * D + h * 64;
#pragma unroll
      for (int d0 = 0; d0 < 4; ++d0) qr[d0] = *reinterpret_cast<const bf16x8*>(&Qw[(long)r32 * D + d0 * 16 + hi * 8]); }
    float R = 1.f; f32x16 o[2]; o[0] = f32x16{}; o[1] = f32x16{};
    const int tloc0 = 32 * (wid & 1) + r32 - 16 * hi;
    const lds_cptr kp0 = (lds_cptr)shm + hi * 1024 + r32 * 16;
    const lds_cptr vp0 = (lds_cptr)shm + 8192 + hi * 1024 + ((lane & 15) >> 2) * 64 + ((lane >> 4) & 1) * 32 + (lane & 3) * 8;
    bool mydone = false;
    for (int it = 0; it <= jmax; ++it) {
        const int j = jmax - it, slot = it & 1;
        ATT_WAIT_BAR(0);
        { unsigned all = 1u;
#pragma unroll
          for (int w = 0; w < NWAVES; ++w) all &= flags[w];
          if (all) break; }
        if (j > 0) SB_DMA(j - 1, slot ^ 1);
        if (j <= jw && !mydone) {
            f32x16 p0 = f32x16{}, p1 = f32x16{};
            const lds_cptr kp = kp0 + slot * 16384;
#pragma unroll
            for (int d0 = 0; d0 < 4; ++d0) {
                const bf16x8 k0 = *(const LAS bf16x8*)(kp + d0 * 2048), k1 = *(const LAS bf16x8*)(kp + d0 * 2048 + 512);
                p0 = __builtin_amdgcn_mfma_f32_32x32x16_bf16(k0, qr[d0], p0, 0, 0, 0); p1 = __builtin_amdgcn_mfma_f32_32x32x16_bf16(k1, qr[d0], p1, 0, 0, 0);
            }
            if (j == jw) {
#pragma unroll
                for (int r = 0; r < 16; ++r) { if (r >= tloc0) p0[r] = -INFINITY; if (r + 32 >= tloc0) p1[r] = -INFINITY; }
            }
            float TA = 1.f, TB = 1.f;
#pragma unroll
            for (int r = 0; r < 16; ++r) { p0[r] = __builtin_amdgcn_rcpf(1.f + __builtin_amdgcn_exp2f(p0[r])); p1[r] = __builtin_amdgcn_rcpf(1.f + __builtin_amdgcn_exp2f(p1[r])); TA *= p0[r]; TB *= p1[r]; }
            const float TAp = partner(TA, hi), TBp = partner(TB, hi);
            const float preB = hi ? R : R * TBp;
            const float preA = hi ? (R * TB) * TBp : ((R * TBp) * TB) * TAp;
            R = (((R * TA) * TB) * TAp) * TBp;
            { float e = preB;
#pragma unroll
              for (int r = 15; r >= 0; --r) { const float f = p1[r]; p1[r] = (1.f - f) * e; e *= f; }
              e = preA;
#pragma unroll
              for (int r = 15; r >= 0; --r) { const float f = p0[r]; p0[r] = (1.f - f) * e; e *= f; } }
            const u32x4 pw0 = ATT_PACK(p0, 0), pw1 = ATT_PACK(p0, 8), pw2 = ATT_PACK(p1, 0), pw3 = ATT_PACK(p1, 8);
            const lds_cptr vp = vp0 + slot * 16384;
#pragma unroll
            for (int e = 0; e < 2; ++e) {
#define SB_PV(ks, PW) do { const s16x4 lo_ = vtr(vp + e * 4096 + ((ks) >> 1) * 2048 + ((ks) & 1) * 512), hi_ = vtr(vp + e * 4096 + ((ks) >> 1) * 2048 + ((ks) & 1) * 512 + 256); \
                const bf16x8 vb_ = (bf16x8){lo_[0], lo_[1], lo_[2], lo_[3], hi_[0], hi_[1], hi_[2], hi_[3]}; \
                o[e] = __builtin_amdgcn_mfma_f32_32x32x16_bf16(__builtin_bit_cast(bf16x8, PW), vb_, o[e], 0, 0, 0); } while (0)
                SB_PV(0, pw0); SB_PV(1, pw1); SB_PV(2, pw2); SB_PV(3, pw3);
#undef SB_PV
            }
            mydone = __all(R < 1e-30f);
            if (mydone && lane == 0) flags[wid] = 1u;
        }
    }
    ATT_WAIT_BAR(0);
    { bf16* Ow = O + (rowbase + q0 + 32 * wid) * D + h * 64;
      LAS bf16* stg = (LAS bf16*)(shm + 32768 + wid * 4096);
#pragma unroll
      for (int r = 0; r < 16; ++r) { const int orow = crow(r, hi);
#pragma unroll
          for (int e = 0; e < 2; ++e) stg[orow * 64 + e * 32 + r32] = (bf16)(cvtpk_s(o[e][r], 0.f) & 0xffffu); }
      asm volatile("s_waitcnt lgkmcnt(0)" ::: "memory");
#pragma unroll
      for (int i = 0; i < 4; ++i) { const int row = i * 8 + (lane >> 3), ch = lane & 7; const u32x4 v = *(const LAS u32x4*)(stg + row * 64 + ch * 8); *(u32x4*)(Ow + (long)row * D + ch * 8) = v; } }
    ATT_WAIT_BAR(0);
#undef SB_DMA
}
}

struct Args {
    const float* in[23]; float* out; unsigned char* ws; int ph_lo, ph_hi;
};

__global__ void __launch_bounds__(NTHR, 2) fwd(Args args) {
    extern __shared__ __attribute__((aligned(16))) unsigned char lds_raw[];
    LAS unsigned char* lds = (LAS unsigned char*)lds_raw;
    volatile LAS unsigned* MISC = (volatile LAS unsigned*)(lds + MISC_OFF);
    const int G = gridDim.x, bx = blockIdx.x;
#define PHASE_IDS() int tid = threadIdx.x; asm volatile("" : "+v"(tid)); const int lane = tid & 63, wave = __builtin_amdgcn_readfirstlane(tid >> 6); const int gw = vcu * NWAVES + wave; (void)lane; (void)gw
    const int vcu = (G % 8 == 0) ? (bx % 8) * (G / 8) + bx / 8 : bx;
    unsigned char* ws = args.ws;
    gu32* ctl = (gu32*)(ws + WS_CTL);
    for (int u = threadIdx.x; u < (LDS_BYTES - MISC_OFF) / 4; u += NTHR) ((LAS unsigned*)(lds + MISC_OFF))[u] = 0u;
    __syncthreads();
    XcdBarrier bar; bar.bar = (unsigned*)ctl + CW_BAR; bar.x = 0; bar.st = nullptr;
    if (MK_ONE_LAUNCH) bar = xcd_barrier_post((unsigned*)ctl + CW_BAR, MISC + 8);
#define GRID_BAR() do { if (MK_ONE_LAUNCH) xcd_barrier(bar); } while (0)
    const int lo = args.ph_lo, hi = args.ph_hi;
#define IN(k) (lo <= (k) && (k) < hi)
#define BOTH(k) (IN(k) && IN((k) + 1))
    const float* x_in = args.in[0]; const float* c_in = args.in[1];
    const float* norm1_g = args.in[2]; const float* norm2_g = args.in[3];
    const float* ada_w = args.in[4]; const float* ada_b = args.in[5];
    float* xs = args.out;
    float* mod = (float*)(ws + WS_MOD);
    bf16* XN = (bf16*)(ws + WS_XN); bf16* Qb = (bf16*)(ws + WS_Q); bf16* Kb = (bf16*)(ws + WS_K); bf16* Vb = (bf16*)(ws + WS_V); bf16* Ob = (bf16*)(ws + WS_O);
    bf16* Hm = (bf16*)(ws + WS_HM); bf16* Yd = (bf16*)(ws + WS_YD);
    const int NGW = G * NWAVES;

    if (IN(0)) {
            PHASE_IDS();
        if (bx < 192) {
            LAS float* cond = (LAS float*)lds; LAS float* red = (LAS float*)(lds + 32768);
            const int l = bx / 96, j0 = (bx % 96) * 64;
            for (int i = tid; i < BATCH * D; i += NTHR) { const float v = c_in[i]; cond[i] = v / (1.f + __expf(-v)); }
            __syncthreads();
            float acc[BATCH];
#pragma unroll
            for (int b = 0; b < BATCH; ++b) acc[b] = 0.f;
            const float* W = ada_w + (size_t)l * D * 6 * D + j0 + lane;
#pragma unroll 8
            for (int k = wave * 128; k < wave * 128 + 128; ++k) {
                const float w = W[(size_t)k * 6 * D];
#pragma unroll
                for (int b = 0; b < BATCH; ++b) acc[b] += cond[b * D + k] * w;
            }
#pragma unroll
            for (int b = 0; b < BATCH; ++b) red[(wave * BATCH + b) * 64 + lane] = acc[b];
            __syncthreads();
            { const int b = tid >> 6, j = tid & 63; float s = ada_b[(size_t)l * 6 * D + j0 + j];
#pragma unroll
              for (int w = 0; w < NWAVES; ++w) s += red[(w * BATCH + b) * 64 + j];
              mod[((size_t)l * BATCH + b) * 6 * D + j0 + j] = s; }
        }
        if (BOTH(0)) GRID_BAR();
    }

    if (IN(1)) {
            PHASE_IDS();
        LAS float* scr = (LAS float*)(lds + wave * 16384);
        constexpr int I_IN = 16 * 96, I_OUT = 16 * 32, I_G = 32 * 256, I_D = 32 * 256, I_LAYER = I_IN + I_OUT + 2 * I_G + I_D;
        for (int it = gw; it < DEPTH * I_LAYER; it += NGW) {
            const int l = it / I_LAYER; int r = it % I_LAYER;
            unsigned char* wl = ws + WS_W + (size_t)l * W_LAYER;
            if (r < I_IN) { const float* W = args.in[l == 0 ? 6 : 13]; transpose_item(W, D, 3 * D, (bf16*)(wl + W_IN), 32 * (r % 96), scr, 64 * (r / 96), 32 * (r % 96), lane); continue; } r -= I_IN;
            if (r < I_OUT) { const float* W = args.in[l == 0 ? 7 : 14]; transpose_item(W, D, D, (bf16*)(wl + W_OUT), 32 * (r % 32), scr, 64 * (r / 32), 32 * (r % 32), lane); continue; } r -= I_OUT;
            if (r < 2 * I_G) { const int up = r / I_G; r %= I_G; const int e = r / 256, rr = r % 256, n0 = 32 * (rr % 16);
                const float* W = args.in[up ? 20 : 19] + ((size_t)l * NE + e) * D * FH;
                transpose_item(W, D, FH, (bf16*)(wl + W_GU) + (size_t)e * D * D, (n0 / 128) * 256 + (n0 % 128) + up * 128, scr, 64 * (rr / 16), n0, lane); continue; } r -= 2 * I_G;
            { const int e = r / 256, rr = r % 256; const float* W = args.in[21] + ((size_t)l * NE + e) * FH * D;
              transpose_item(W, FH, D, (bf16*)(wl + W_DN) + (size_t)e * D * FH, 32 * (rr % 32), scr, 64 * (rr / 32), 32 * (rr % 32), lane); }
        }
        for (int m = gw; m < NTOK; m += NGW) {
            const int b = m / SEQ; const float* mb = mod + (size_t)b * 6 * D;
            f32x4 v[4]; const GAS f32x4* xr = (const GAS f32x4*)(x_in + (size_t)m * D) + lane;
#pragma unroll
            for (int j = 0; j < 4; ++j) v[j] = xr[64 * j];
            norm_mod(v, norm1_g, mb, mb + D, lane, 1e-6f);
            store_row_bf16(XN + (size_t)m * D, v, lane);
        }
        if (BOTH(1)) GRID_BAR();
    }

#pragma unroll 1
    for (int l = 0; l < DEPTH; ++l) {
        const int pb = 2 + 8 * l;
        unsigned char* wl = ws + WS_W + (size_t)l * W_LAYER;
        const float* modl = mod + (size_t)l * BATCH * 6 * D;
        int* eid = (int*)(ws + WS_EID + l * LSTRIDE); float* ew = (float*)(ws + WS_EW + l * LSTRIDE); int* hist = (int*)(ws + WS_HIST + l * LSTRIDE);
        int* sop = (int*)(ws + WS_SOP + l * LSTRIDE); int* stok = (int*)(ws + WS_STOK + l * LSTRIDE); int* tiles = (int*)(ws + WS_TILES + l * LSTRIDE);

        if (IN(pb + 0)) {
            PHASE_IDS();
            pg8::StaticOrder S; S.init(NTOK, 3 * D, G, bx, (const bf16*)(wl + W_IN));
            pg8::EpiBf16 E{Qb, D, D, (size_t)(WS_K - WS_Q) / 2, C2};
            pg8::gemm_phase<pg8::EpiBf16, pg8::StaticOrder, false>(lds, XN, D, nullptr, S, E);
            if (BOTH(pb + 0)) GRID_BAR();
        }
        if (IN(pb + 1)) {
            PHASE_IDS();
            if (l == 0) {
                const float* lq1 = args.in[8]; const float* lk1 = args.in[9]; const float* lq2 = args.in[10]; const float* lk2 = args.in[11];
                const float lam = __expf(wave_sum(lq1[lane] * lk1[lane])) - __expf(wave_sum(lq2[lane] * lk2[lane])) + 0.2f;
                const int bh = vcu >> 2, s4 = vcu & 3;
                for (int i = 0; i < 4; ++i) { const int qb = (i == 0) ? s4 : (i == 1) ? 7 - s4 : (i == 2) ? 8 + s4 : 15 - s4;
                    att::diff_unit(bh >> 3, bh & 7, qb, Qb, Kb, Vb, Ob, lds, lam, args.in[12], tid); }
            } else {
                const int bh = vcu >> 1, hf = vcu & 1;
                for (int i = 0; i < 4; ++i) { const int qb = (i == 0) ? 2 * hf : (i == 1) ? 7 - 2 * hf : (i == 2) ? 2 * hf + 1 : 6 - 2 * hf;
                    att::sb_unit(bh >> 4, bh & 15, qb, Qb, Kb, Vb, Ob, lds, tid); }
            }
            if (BOTH(pb + 1)) GRID_BAR();
        }
        if (IN(pb + 2)) {
            PHASE_IDS();
            pg8::StaticOrder S; S.init(NTOK, D, G, bx, (const bf16*)(wl + W_OUT));
            pg8::EpiResid E{xs, l == 0 ? x_in : xs, D, modl + 2 * D, 6 * D, SEQ};
            pg8::gemm_phase<pg8::EpiResid, pg8::StaticOrder, false>(lds, Ob, D, nullptr, S, E);
            if (BOTH(pb + 2)) GRID_BAR();
        }
        if (IN(pb + 3)) {
            PHASE_IDS();
            LAS float* wl_ = (LAS float*)lds;
            LAS int* lhist = (LAS int*)(lds + MISC_OFF + 256);
            const float* rgw = args.in[15] + (size_t)l * D * NG; const float* rgb = args.in[16] + l * NG; const float* rew = args.in[17] + (size_t)l * D * NE; const float* reb = args.in[18] + l * NE;
            for (int i = tid; i < D * NG; i += NTHR) wl_[(i & 3) * D + (i >> 2)] = rgw[i];
            for (int i = tid; i < D * NE; i += NTHR) wl_[(4 + (i & 31)) * D + (i >> 5)] = rew[i];
            if (tid < NE) lhist[tid] = 0;
            __syncthreads();
            for (int i = 0; i < 8; ++i) {
                const int tok = bx * 64 + wave * 8 + i;
                const int b = tok / SEQ; const float* mb = modl + (size_t)b * 6 * D;
                f32x4 v[4]; const GAS f32x4* xr = (const GAS f32x4*)(xs + (size_t)tok * D) + lane;
#pragma unroll
                for (int j = 0; j < 4; ++j) v[j] = xr[64 * j];
                norm_mod(v, norm2_g + l * D, mb + 3 * D, mb + 4 * D, lane, 1e-6f);
                store_row_bf16(XN + (size_t)tok * D, v, lane);
                float gl[4];
#pragma unroll
                for (int g = 0; g < 4; ++g) { float s = 0.f;
#pragma unroll
                    for (int j = 0; j < 4; ++j) { const f32x4 w = *(const LAS f32x4*)(wl_ + g * D + 4 * lane + 256 * j); s += (v[j].x * w.x + v[j].y * w.y) + (v[j].z * w.z + v[j].w * w.w); }
                    gl[g] = wave_sum(s) + rgb[g]; }
                int gi = 0; float gm = gl[0];
#pragma unroll
                for (int g = 1; g < 4; ++g) if (gl[g] > gm) { gm = gl[g]; gi = g; }
                float gs = 0.f;
#pragma unroll
                for (int g = 0; g < 4; ++g) gs += __expf(gl[g] - gm);
                const float gwt = 1.0f / gs;
                gi = __builtin_amdgcn_readfirstlane(gi);
                float v1 = -INFINITY, v2 = -INFINITY; int i1 = 0, i2 = 0;
#pragma unroll
                for (int jx = 0; jx < 8; ++jx) { float s = 0.f; const LAS float* wr_ = wl_ + (4 + gi * 8 + jx) * D;
#pragma unroll
                    for (int j = 0; j < 4; ++j) { const f32x4 w = *(const LAS f32x4*)(wr_ + 4 * lane + 256 * j); s += (v[j].x * w.x + v[j].y * w.y) + (v[j].z * w.z + v[j].w * w.w); }
                    const float ev = wave_sum(s) + reb[gi * 8 + jx];
                    if (ev > v1) { v2 = v1; i2 = i1; v1 = ev; i1 = jx; } else if (ev > v2) { v2 = ev; i2 = jx; } }
                if (lane == 0) {
                    const float e2 = __expf(v2 - v1), den = 1.f / (1.f + e2);
                    eid[tok * 2] = gi * 8 + i1; eid[tok * 2 + 1] = gi * 8 + i2; ew[tok * 2] = gwt * den; ew[tok * 2 + 1] = gwt * e2 * den;
                    atomicAdd((int*)(lhist + gi * 8 + i1), 1); atomicAdd((int*)(lhist + gi * 8 + i2), 1);
                }
            }
            __syncthreads();
            if (tid < NE) hist[bx * NE + tid] = lhist[tid];
            if (BOTH(pb + 3)) GRID_BAR();
        }
        if (IN(pb + 4)) {
            PHASE_IDS();
            LAS int* tot = (LAS int*)lds; LAS int* bef = tot + 16 * NE; LAS int* pst = bef + 16 * NE; LAS int* tote = pst + 64; LAS int* befe = tote + 32; LAS int* le = befe + 32;
            { const int e = tid & 31, part = tid >> 5; int s = 0, sb = 0;
              for (int w = part * 16; w < part * 16 + 16; ++w) { const int hv = hist[w * NE + e]; s += hv; if (w < bx) sb += hv; }
              tot[part * NE + e] = s; bef[part * NE + e] = sb; }
            __syncthreads();
            if (tid < NE) { int s = 0, sb = 0; for (int p = 0; p < 16; ++p) { s += tot[p * NE + tid]; sb += bef[p * NE + tid]; } tote[tid] = s; befe[tid] = sb; }
            __syncthreads();
            if (tid == 0) { int off = 0; for (int e = 0; e < NE; ++e) { pst[e] = off; off += (tote[e] + 255) / 256 * 256; } pst[NE] = off; }
            if (tid < 128) le[tid] = eid[(bx * 64) * 2 + tid];
            __syncthreads();
            if (tid < 128) { const int e = le[tid]; int rank = 0; for (int q = 0; q < tid; ++q) rank += (le[q] == e) ? 1 : 0;
                const int s = pst[e] + befe[e] + rank; stok[s] = bx * 64 + (tid >> 1); sop[(bx * 64) * 2 + tid] = s; }
            if (bx < NE) { const int e = bx; for (int s = pst[e] + tote[e] + tid; s < pst[e + 1]; s += NTHR) stok[s] = 0; }
            if (bx == NE) { if (tid < NE) { for (int t = pst[tid] / 256; t < pst[tid + 1] / 256; ++t) tiles[1 + t] = tid; } if (tid == 0) tiles[0] = pst[NE] / 256; }
            if (BOTH(pb + 4)) GRID_BAR();
        }
        if (IN(pb + 5)) {
            PHASE_IDS();
            LAS int* tl = (LAS int*)(lds + AUX_OFF); LAS int* gidx = tl + 256;
            if (tid < 1 + MAX_TILES) tl[tid] = tiles[tid + vzero()];
            __syncthreads();
            pg8::GroupedOrder S{tl, G, vcu, (const bf16*)(wl + W_GU), (size_t)D * D};
            { pg8::Unit u; for (int i = 0; i < 3 && S.next(i, u); ++i) { if (tid < 256) gidx[i * 256 + tid] = stok[u.pm * 256 + tid]; } }
            __syncthreads();
            pg8::EpiSwiGLU E{Hm, FH};
            pg8::gemm_phase<pg8::EpiSwiGLU, pg8::GroupedOrder, true>(lds, XN, D, gidx, S, E);
            if (BOTH(pb + 5)) GRID_BAR();
        }
        if (IN(pb + 6)) {
            PHASE_IDS();
            LAS int* tl = (LAS int*)(lds + AUX_OFF);
            if (tid < 1 + MAX_TILES) tl[tid] = tiles[tid + vzero()];
            __syncthreads();
            pg8::GroupedOrder S{tl, G, vcu, (const bf16*)(wl + W_DN), (size_t)D * FH};
            pg8::EpiBf16 E{Yd, D, 0, 0, 1.f};
            pg8::gemm_phase<pg8::EpiBf16, pg8::GroupedOrder, false>(lds, Hm, FH, nullptr, S, E);
            if (BOTH(pb + 6)) GRID_BAR();
        }
        if (IN(pb + 7)) {
            PHASE_IDS();
            for (int m = gw; m < NTOK; m += NGW) {
                const int b = m / SEQ; const float* mb = modl + (size_t)b * 6 * D;
                const int vz = vzero();
                const int s0 = sop[m * 2 + vz], s1 = sop[m * 2 + 1 + vz]; const float w0 = ew[m * 2 + vz], w1 = ew[m * 2 + 1 + vz];
                f32x4 v[4]; GAS f32x4* xr = (GAS f32x4*)(xs + (size_t)m * D) + lane;
                const GAS v2u* y0 = (const GAS v2u*)(Yd + (size_t)s0 * D) + lane; const GAS v2u* y1 = (const GAS v2u*)(Yd + (size_t)s1 * D) + lane;
#pragma unroll
                for (int j = 0; j < 4; ++j) {
                    const f32x4 xv = xr[64 * j]; const v2u a = y0[64 * j], c = y1[64 * j]; const f32x4 g2 = *(const f32x4*)(mb + 5 * D + 4 * lane + 256 * j);
                    f32x4 y; y.x = w0 * bf_lo(a.x) + w1 * bf_lo(c.x); y.y = w0 * bf_hi(a.x) + w1 * bf_hi(c.x); y.z = w0 * bf_lo(a.y) + w1 * bf_lo(c.y); y.w = w0 * bf_hi(a.y) + w1 * bf_hi(c.y);
                    v[j] = xv + g2 * y;
                }
                if (l + 1 < DEPTH) {
#pragma unroll
                    for (int j = 0; j < 4; ++j) xr[64 * j] = v[j];
                    const float* mn = mod + ((size_t)(l + 1) * BATCH + b) * 6 * D;
                    norm_mod(v, norm1_g + (l + 1) * D, mn, mn + D, lane, 1e-6f);
                    store_row_bf16(XN + (size_t)m * D, v, lane);
                } else {
                    norm_mod(v, args.in[22], nullptr, nullptr, lane, 1e-6f);
#pragma unroll
                    for (int j = 0; j < 4; ++j) xr[64 * j] = v[j];
                }
            }
            if (BOTH(pb + 7)) GRID_BAR();
        }
    }
#undef IN
#undef BOTH
}

extern "C" void kernel_launch(void* const* d_in, const int* in_sizes, int n_in, void* d_out, int out_size, void* d_ws, size_t ws_size, hipStream_t stream) {
    static int grid = 0;
    if (grid == 0) {
        if (n_in != 23 || out_size != NTOK * D || ws_size < WS_END) { fprintf(stderr, "kernel_launch: unexpected shapes (n_in %d out %d ws %zu)\n", n_in, out_size, ws_size); grid = -1; return; }
        int dev = 0, cus = 0, per_cu = 0;
        if (hipGetDevice(&dev) != hipSuccess || hipDeviceGetAttribute(&cus, hipDeviceAttributeMultiprocessorCount, dev) != hipSuccess) { grid = -1; return; }
        if (hipFuncSetAttribute((const void*)fwd, hipFuncAttributeMaxDynamicSharedMemorySize, LDS_BYTES) != hipSuccess) { fprintf(stderr, "kernel_launch: hipFuncSetAttribute failed\n"); grid = -1; return; }
        if (hipOccupancyMaxActiveBlocksPerMultiprocessor(&per_cu, (const void*)fwd, NTHR, LDS_BYTES) != hipSuccess || per_cu < 1) fprintf(stderr, "kernel_launch: occupancy query reports %d\n", per_cu);
        (void)hipGetLastError();
        grid = cus;
        if (grid != 256) { fprintf(stderr, "kernel_launch: built for 256 CUs, found %d\n", cus); grid = -1; return; }
    }
    if (grid < 0) return;
    (void)in_sizes;
    if (hipMemsetAsync((char*)d_ws + WS_CTL, 0, CTL_ZERO_BYTES, stream) != hipSuccess) return;
    Args a{};
    for (int i = 0; i < 23; ++i) a.in[i] = (const float*)d_in[i];
    a.out = (float*)d_out; a.ws = (unsigned char*)d_ws;
#if MK_ONE_LAUNCH
    a.ph_lo = 0; a.ph_hi = NPHASE;
    hipLaunchKernelGGL(fwd, dim3(grid), dim3(NTHR), LDS_BYTES, stream, a);
#else
    for (int p = 0; p < NPHASE; ++p) { a.ph_lo = p; a.ph_hi = p + 1; hipLaunchKernelGGL(fwd, dim3(grid), dim3(NTHR), LDS_BYTES, stream, a); }
#endif
}
```

```cpp
#include <hip/hip_runtime.h>
#include <cstdio>
#include <cstdint>
#include <cmath>

#ifndef REPMASK
#define REPMASK 0
#endif
#define NREP(bit, cond) ((((REPMASK) >> (bit)) & 1) && (cond) ? 2 : 1)
#ifndef MK_ONE_LAUNCH
#define MK_ONE_LAUNCH 1
#endif

namespace pg8 {
#define PG8_LAS __attribute__((address_space(3)))
typedef unsigned short bf16_t;
typedef short bf16x8 __attribute__((ext_vector_type(8)));
typedef float f32x4 __attribute__((ext_vector_type(4)));
typedef unsigned u32x4 __attribute__((ext_vector_type(4)));
constexpr int BM = 256, BK = 64, HALF = 128, HTB = HALF * BK * 2, NXCD = 8, WGM = 8;

__host__ __device__ __forceinline__ int lds_byte(int r, int c) { const int st = (r >> 4) * 2 + (c >> 5), rr = r & 15, cc = c & 31, ob = rr * 64 + cc * 2; return st * 1024 + (ob ^ (((ob >> 9) & 1) << 5)); }
__host__ __device__ __forceinline__ void stage_rc(int b, int& R, int& C) { const int st = b / 1024, sb = b % 1024, swz = sb ^ (((sb >> 9) & 1) << 5); R = (st >> 1) * 16 + swz / 64; C = (st & 1) * 32 + (swz % 64) / 2; }
__host__ __device__ __forceinline__ int perm32(int rho) { const int n = rho >> 4, i = rho & 15; return 8 * (i >> 2) + 4 * n + (i & 3); }

struct Unit { int pm, pn; const bf16_t* Bt; };

struct StaticOrder {
    int nM, nN, nwg, G, c; const bf16_t* Bt;
    __device__ void init(int M, int N, int G_, int c_, const bf16_t* Bt_) { nM = M / BM; nN = N / BM; nwg = nM * nN; G = G_; c = c_; Bt = Bt_; }
    __device__ bool next(int i, Unit& u) const {
        const long L = (long)i * G + c; if (L >= nwg) return false;
        int wgid = (int)L; { const int q = nwg / NXCD, r = nwg % NXCD, xcd = wgid % NXCD, off = wgid / NXCD; wgid = (xcd < r ? xcd * (q + 1) : r * (q + 1) + (xcd - r) * q) + off; }
        const int nig = WGM * nN, gid = wgid / nig, fm = gid * WGM, gsz = (nM - fm) < WGM ? (nM - fm) : WGM;
        u.pm = fm + ((wgid % nig) % gsz); u.pn = (wgid % nig) / gsz; u.Bt = Bt; return true;
    }
};
struct GroupedOrder {
    const PG8_LAS int* tl; int G, c; const bf16_t* Bt; size_t estride;
    __device__ bool next(int i, Unit& u) const {
        const int L = i * G + c; const int nt = tl[0]; if (L >= nt * 4) return false;
        u.pm = L >> 2; u.pn = L & 3; u.Bt = Bt + (size_t)tl[1 + (L >> 2)] * estride; return true;
    }
};

__device__ __forceinline__ unsigned cvt_pk_bf16(float lo, float hi) { unsigned r; asm volatile("v_cvt_pk_bf16_f32 %0, %1, %2" : "=v"(r) : "v"(lo), "v"(hi)); return r; }

struct EpiBf16 {
    static constexpr bool PERM = true;
    bf16_t* O; int ldc; int split_cols; size_t split_stride; float scale0;
    __device__ __forceinline__ void operator()(const f32x4 (&acc)[2][2][4][2], const Unit& u, int wr, int wc, int fr, int fq) const {
        const int row0 = u.pm * BM + wr * 64 + fr; int colt = u.pn * BM; bf16_t* base = O;
        float sc = 1.f; if (split_cols) { const int t = colt / split_cols; base += (size_t)t * split_stride; colt -= t * split_cols; if (t == 0) sc = scale0; }
        const int col0 = colt + wc * 32 + 8 * fq;
#pragma unroll
        for (int ai = 0; ai < 2; ++ai)
#pragma unroll
            for (int m = 0; m < 4; ++m) { bf16_t* rowp = base + (size_t)(row0 + ai * HALF + m * 16) * ldc + col0;
#pragma unroll
                for (int bj = 0; bj < 2; ++bj) { const f32x4 v0 = acc[ai][bj][m][0] * sc, v1 = acc[ai][bj][m][1] * sc;
                    u32x4 w; w.x = cvt_pk_bf16(v0[0], v0[1]); w.y = cvt_pk_bf16(v0[2], v0[3]); w.z = cvt_pk_bf16(v1[0], v1[1]); w.w = cvt_pk_bf16(v1[2], v1[3]);
                    *(u32x4*)(rowp + bj * HALF) = w; } }
    }
};
struct EpiResid {
    static constexpr bool PERM = false;
    float* C; const float* X; int ldc; const float* gate; int gstride; int rows_per_batch;
    __device__ __forceinline__ void operator()(const f32x4 (&acc)[2][2][4][2], const Unit& u, int wr, int wc, int fr, int fq) const {
        const int row0 = u.pm * BM + wr * 64 + fr, col0 = u.pn * BM + wc * 32 + 4 * fq;
        const float* gp = gate + (size_t)((u.pm * BM) / rows_per_batch) * gstride + col0;
        f32x4 gv[2][2];
#pragma unroll
        for (int bj = 0; bj < 2; ++bj)
#pragma unroll
            for (int n = 0; n < 2; ++n) gv[bj][n] = *(const f32x4*)(gp + bj * HALF + n * 16);
#pragma unroll
        for (int ai = 0; ai < 2; ++ai)
#pragma unroll
            for (int m = 0; m < 4; ++m) { const size_t ro = (size_t)(row0 + ai * HALF + m * 16) * ldc + col0;
#pragma unroll
                for (int bj = 0; bj < 2; ++bj)
#pragma unroll
                    for (int n = 0; n < 2; ++n) { const f32x4 xv = *(const f32x4*)(X + ro + bj * HALF + n * 16); *(f32x4*)(C + ro + bj * HALF + n * 16) = xv + gv[bj][n] * acc[ai][bj][m][n]; } }
    }
};
struct EpiSwiGLU {
    static constexpr bool PERM = true;
    bf16_t* H; int ldh;
    __device__ __forceinline__ void operator()(const f32x4 (&acc)[2][2][4][2], const Unit& u, int wr, int wc, int fr, int fq) const {
        const int row0 = u.pm * BM + wr * 64 + fr, col0 = u.pn * HALF + wc * 32 + 8 * fq;
#pragma unroll
        for (int ai = 0; ai < 2; ++ai)
#pragma unroll
            for (int m = 0; m < 4; ++m) { bf16_t* rowp = H + (size_t)(row0 + ai * HALF + m * 16) * ldh + col0;
                float hv[8];
#pragma unroll
                for (int n = 0; n < 2; ++n)
#pragma unroll
                    for (int j = 0; j < 4; ++j) { const float g = acc[ai][0][m][n][j], uu = acc[ai][1][m][n][j]; hv[n * 4 + j] = g * __builtin_amdgcn_rcpf(1.f + __builtin_amdgcn_exp2f(-1.4426950408889634f * g)) * uu; }
                u32x4 w; w.x = cvt_pk_bf16(hv[0], hv[1]); w.y = cvt_pk_bf16(hv[2], hv[3]); w.z = cvt_pk_bf16(hv[4], hv[5]); w.w = cvt_pk_bf16(hv[6], hv[7]);
                *(u32x4*)rowp = w; }
    }
};

template <class Epi, class Sched, bool GATHER>
__device__ __forceinline__ void gemm_phase(PG8_LAS unsigned char* lds, const bf16_t* Ab_, const int K, const PG8_LAS int* gidx, const Sched& S, const Epi& E, const int tid) {
    const int wid = __builtin_amdgcn_readfirstlane(tid >> 6), lane = tid & 63, wr = wid >> 2, wc = wid & 3, fr = lane & 15, fq = lane >> 4;
    const int nt = K / BK;
    const char* Ab = (const char*)Ab_;
    int RA[2]; unsigned CA2[2], voffB[2];
#pragma unroll
    for (int i = 0; i < 2; ++i) { int R, C; stage_rc(tid * 16 + i * 8192, R, C); const int Rb = Epi::PERM ? ((R & ~31) + perm32(R & 31)) : R;
        RA[i] = R; CA2[i] = (unsigned)C * 2u; voffB[i] = (unsigned)(Rb * K + C) * 2u; }
    const unsigned rowbytes = (unsigned)K * 2u;
    const unsigned kstep = (unsigned)(BK * 2);
    const size_t hstep = (size_t)HALF * K * 2;
    const size_t tstep = 2 * hstep;
    const unsigned ldsw = (unsigned)wid * 1024u;
    const int aoff = lds_byte(wr * 64 + fr, fq * 8), boff = lds_byte(wc * 32 + fr, fq * 8);
#define PG8_SA(b, h) (((b) * 2 + (h)) * HTB)
#define PG8_SB(b, h) ((4 + (b) * 2 + (h)) * HTB)
#define PG8_STAGEB(bufoff, gbase) do { _Pragma("unroll") for (int _i = 0; _i < 2; ++_i) \
        __builtin_amdgcn_global_load_lds((const unsigned*)((const char*)(gbase) + voffB[_i]), (PG8_LAS unsigned*)(lds + (bufoff) + ldsw + _i * 8192), 16, 0, 0); } while (0)
#define PG8_STAGEA(bufoff, o0, o1) do { \
        __builtin_amdgcn_global_load_lds((const unsigned*)(Ab + (o0)), (PG8_LAS unsigned*)(lds + (bufoff) + ldsw), 16, 0, 0); \
        __builtin_amdgcn_global_load_lds((const unsigned*)(Ab + (o1)), (PG8_LAS unsigned*)(lds + (bufoff) + ldsw + 8192), 16, 0, 0); } while (0)
#define PG8_LDA(dst, b, h) do { _Pragma("unroll") for (int m = 0; m < 4; ++m) _Pragma("unroll") for (int k = 0; k < 2; ++k) dst[m][k] = *(const PG8_LAS bf16x8*)(lds + PG8_SA(b, h) + aoff + m * 2048 + k * 1024); } while (0)
#define PG8_LDB(dst, b, h) do { _Pragma("unroll") for (int n = 0; n < 2; ++n) _Pragma("unroll") for (int k = 0; k < 2; ++k) dst[n][k] = *(const PG8_LAS bf16x8*)(lds + PG8_SB(b, h) + boff + n * 2048 + k * 1024); } while (0)
#define PG8_MMA(ai, bj, At, Bt) do { __builtin_amdgcn_s_setprio(1); _Pragma("unroll") for (int m = 0; m < 4; ++m) _Pragma("unroll") for (int n = 0; n < 2; ++n) _Pragma("unroll") for (int k = 0; k < 2; ++k) \
        acc[ai][bj][m][n] = __builtin_amdgcn_mfma_f32_16x16x32_bf16(Bt[n][k], At[m][k], acc[ai][bj][m][n], 0, 0, 0); __builtin_amdgcn_s_setprio(0); } while (0)
#define PG8_WAIT_V(n) asm volatile("s_waitcnt vmcnt(" #n ")" ::: "memory")
#define PG8_WAIT_L(n) asm volatile("s_waitcnt lgkmcnt(" #n ")" ::: "memory")
#define PG8_BAR __builtin_amdgcn_s_barrier()
#define PG8_SCHED __builtin_amdgcn_sched_barrier(0)
#define PG8_MKOFF(dst, u, ui_) do { _Pragma("unroll") for (int h = 0; h < 2; ++h) _Pragma("unroll") for (int i = 0; i < 2; ++i) { \
        int row_ = (u).pm * BM + h * HALF + RA[i]; if (GATHER) row_ = gidx[(ui_) * BM + h * HALF + RA[i]]; dst[h][i] = (unsigned)row_ * rowbytes + CA2[i]; } } while (0)
    Unit cur, nxt; int ui = 0;
    if (!S.next(0, cur)) return;
    f32x4 acc[2][2][4][2];
#pragma unroll
    for (int a = 0; a < 2; ++a)
#pragma unroll
        for (int b = 0; b < 2; ++b)
#pragma unroll
            for (int m = 0; m < 4; ++m)
#pragma unroll
                for (int n = 0; n < 2; ++n) acc[a][b][m][n] = (f32x4){0.f, 0.f, 0.f, 0.f};
    bf16x8 At[4][2], B0[2][2], B1[2][2];
    unsigned curo[2][2], nxto[2][2];
    PG8_MKOFF(curo, cur, 0);
    const char* cB = (const char*)cur.Bt + (size_t)cur.pn * tstep;
    PG8_STAGEB(PG8_SB(0, 0), cB); PG8_STAGEB(PG8_SB(0, 1), cB + hstep); PG8_STAGEA(PG8_SA(0, 0), curo[0][0], curo[0][1]); PG8_STAGEA(PG8_SA(0, 1), curo[1][0], curo[1][1]);
    if (wr == 1) PG8_BAR;
    PG8_WAIT_V(2); PG8_BAR;
    PG8_STAGEB(PG8_SB(1, 0), cB + kstep); PG8_STAGEA(PG8_SA(1, 0), curo[0][0] + kstep, curo[0][1] + kstep); PG8_STAGEB(PG8_SB(1, 1), cB + hstep + kstep);
    PG8_WAIT_V(6); PG8_BAR;
    for (;;) {
        const bool has_next = S.next(ui + 1, nxt);
        if (has_next) { PG8_MKOFF(nxto, nxt, ui + 1); } else {
#pragma unroll
            for (int h = 0; h < 2; ++h)
#pragma unroll
                for (int i = 0; i < 2; ++i) nxto[h][i] = curo[h][i]; }
        const char* nB = has_next ? (const char*)nxt.Bt + (size_t)nxt.pn * tstep : cB;
        for (int t = 0; t < nt; t += 2) {
            const bool last = (t == nt - 2);
            const unsigned kb1 = (unsigned)(t + 1) * kstep, kb2 = last ? 0u : (unsigned)(t + 2) * kstep, kb3 = kb2 + kstep;
            const unsigned s00 = last ? nxto[0][0] : curo[0][0], s01 = last ? nxto[0][1] : curo[0][1], s10 = last ? nxto[1][0] : curo[1][0], s11 = last ? nxto[1][1] : curo[1][1];
            const char* b2 = last ? nB : cB + (size_t)(t + 2) * kstep; const char* b3 = b2 + kstep;
            PG8_LDB(B0, 0, 0); PG8_LDB(B1, 0, 1); PG8_SCHED; PG8_LDA(At, 0, 0); PG8_STAGEA(PG8_SA(1, 1), curo[1][0] + kb1, curo[1][1] + kb1);
            PG8_WAIT_V(8); PG8_WAIT_L(0); PG8_BAR; PG8_MMA(0, 0, At, B0); PG8_MMA(0, 1, At, B1); PG8_BAR; PG8_SCHED;
            PG8_LDA(At, 0, 1); PG8_STAGEB(PG8_SB(0, 0), b2); PG8_STAGEB(PG8_SB(0, 1), b2 + hstep); PG8_STAGEA(PG8_SA(0, 0), s00 + kb2, s01 + kb2);
            PG8_WAIT_V(8); PG8_WAIT_L(0); PG8_BAR; PG8_MMA(1, 0, At, B0); PG8_MMA(1, 1, At, B1); PG8_BAR; PG8_SCHED;
            PG8_LDB(B0, 1, 0); PG8_LDB(B1, 1, 1); PG8_SCHED; PG8_LDA(At, 1, 0); PG8_STAGEA(PG8_SA(0, 1), s10 + kb2, s11 + kb2);
            PG8_WAIT_V(8); PG8_WAIT_L(0); PG8_BAR; PG8_MMA(0, 0, At, B0); PG8_MMA(0, 1, At, B1); PG8_BAR; PG8_SCHED;
            PG8_LDA(At, 1, 1); PG8_STAGEB(PG8_SB(1, 0), b3); PG8_STAGEB(PG8_SB(1, 1), b3 + hstep); PG8_STAGEA(PG8_SA(1, 0), s00 + kb3, s01 + kb3);
            PG8_WAIT_V(8); PG8_WAIT_L(0); PG8_BAR; PG8_MMA(1, 0, At, B0); PG8_MMA(1, 1, At, B1); PG8_BAR; PG8_SCHED;
        }
        if (wr == 0) PG8_BAR;
        E(acc, cur, wr, wc, fr, fq);
        if (!has_next) break;
#pragma unroll
        for (int a = 0; a < 2; ++a)
#pragma unroll
            for (int b = 0; b < 2; ++b)
#pragma unroll
                for (int m = 0; m < 4; ++m)
#pragma unroll
                    for (int n = 0; n < 2; ++n) acc[a][b][m][n] = (f32x4){0.f, 0.f, 0.f, 0.f};
        cur = nxt; cB = nB; ++ui;
#pragma unroll
        for (int h = 0; h < 2; ++h)
#pragma unroll
            for (int i = 0; i < 2; ++i) curo[h][i] = nxto[h][i];
        if (wr == 1) PG8_BAR;
    }
    PG8_WAIT_V(0);
    PG8_BAR;
#undef PG8_SA
#undef PG8_SB
#undef PG8_STAGEA
#undef PG8_STAGEB
#undef PG8_LDA
#undef PG8_LDB
#undef PG8_MMA
#undef PG8_WAIT_V
#undef PG8_WAIT_L
#undef PG8_BAR
#undef PG8_SCHED
#undef PG8_MKOFF
}
}

constexpr int NWAVES = 8, NTHR = NWAVES * 64;
constexpr int D = 1024, BATCH = 8, SEQ = 2048, NTOK = BATCH * SEQ, DEPTH = 2;
constexpr int NG = 4, EPG = 8, NE = 32, FH = 512, NPAIR = NTOK * 2;
constexpr int MAX_SLOTS = NPAIR + NE * 256;
constexpr int MAX_TILES = MAX_SLOTS / 256;
constexpr int NPHASE = 2 + 8 * DEPTH;
constexpr float C2 = 0.125f * 1.4426950408889634f;
constexpr float LOG2E = 1.4426950408889634f, LN2 = 0.6931471805599453f;

constexpr size_t MiB = 1u << 20;
constexpr size_t WS_CTL = 0, CTL_ZERO_BYTES = 1 * MiB;
constexpr size_t WS_MOD = 1 * MiB;
constexpr size_t WS_EID = 2 * MiB, WS_EW = 3 * MiB, WS_HIST = 4 * MiB, WS_SOP = 5 * MiB, WS_STOK = 6 * MiB, WS_TILES = 7 * MiB;
constexpr size_t LSTRIDE = 512 * 1024;
constexpr size_t WS_RT = 1 * MiB + 512 * 1024;
constexpr size_t WS_W = 8 * MiB, W_LAYER = 104 * MiB, W_IN = 0, W_OUT = 6 * MiB, W_GU = 8 * MiB, W_DN = 72 * MiB;
constexpr size_t WS_XN = 216 * MiB;
constexpr size_t WS_Q = 248 * MiB, WS_K = 280 * MiB, WS_V = 312 * MiB, WS_O = 344 * MiB;
constexpr size_t WS_HM = 248 * MiB;
constexpr size_t WS_YD = 288 * MiB;
constexpr size_t WS_END = 376 * MiB;
constexpr int CW_BAR = 4096;
constexpr int RING_BYTES = 131072, AUX_OFF = 131072, MISC_OFF = 147456, LDS_BYTES = 163840;

#define GAS __attribute__((address_space(1)))
#define LAS __attribute__((address_space(3)))
typedef unsigned short bf16;
typedef unsigned v4u __attribute__((ext_vector_type(4)));
typedef unsigned v2u __attribute__((ext_vector_type(2)));
typedef float f32x4 __attribute__((ext_vector_type(4)));
typedef GAS unsigned gu32;
#define RLX_AGENT __ATOMIC_RELAXED, __HIP_MEMORY_SCOPE_AGENT
#define LDS_WAIT() asm volatile("s_waitcnt lgkmcnt(0)" ::: "memory")
__device__ __forceinline__ unsigned f2bf(float f) { unsigned u = __builtin_bit_cast(unsigned, f); return (u + 0x7fffu + ((u >> 16) & 1u)) >> 16; }
__device__ __forceinline__ unsigned pk2(float lo, float hi) { return f2bf(lo) | (f2bf(hi) << 16); }
__device__ __forceinline__ float bf_lo(unsigned w) { return __builtin_bit_cast(float, w << 16); }
__device__ __forceinline__ float bf_hi(unsigned w) { return __builtin_bit_cast(float, w & 0xffff0000u); }
__device__ __forceinline__ int vzero() { int z = 0; asm volatile("" : "+v"(z)); return z; }

#define XB_TMO      128
#define XB_XCNT(j)  (256  + 64 * (j))
#define XB_XSUB(j)  (1280 + 64 * (j))
#define XB_XGEN(j)  (2304 + 64 * (j))
#define XB_TOP      3328
#define XB_TOPGEN   3392
#define XCD_BAR_WORDS 3456
#define XB_SPIN_CAP (1u << 18)
__device__ __forceinline__ unsigned xb_ld(unsigned* p)              { return __hip_atomic_load(p, __ATOMIC_RELAXED, __HIP_MEMORY_SCOPE_AGENT); }
__device__ __forceinline__ unsigned xb_add(unsigned* p, unsigned v) { return __hip_atomic_fetch_add(p, v, __ATOMIC_RELAXED, __HIP_MEMORY_SCOPE_AGENT); }
__device__ __forceinline__ unsigned xb_xcc_id() { return (unsigned)__builtin_amdgcn_s_getreg((3 << 11) | 20) & 0xFu; }
#define XB_SPIN(cond, bar) do { unsigned _sp = 0; while (cond) { __builtin_amdgcn_s_sleep(1); \
    if ((++_sp & 255u) == 0u) { if (xb_ld(&(bar)[XB_TMO])) break; if (_sp > XB_SPIN_CAP) { atomicAdd(&(bar)[XB_TMO], 1u); break; } } } } while (0)
struct XcdBarrier { unsigned* bar; unsigned x; volatile LAS unsigned* st; };
__device__ __forceinline__ XcdBarrier xcd_barrier_post(unsigned* bar, volatile LAS unsigned* st) {
    XcdBarrier b; b.bar = bar; b.x = xb_xcc_id(); b.st = st;
    if (threadIdx.x == 0) (void)xb_add(&bar[XB_XCNT(b.x)], 1u);
    return b;
}
__device__ __forceinline__ void xcd_barrier_complete(unsigned* bar, unsigned x, unsigned& nloc, unsigned& nx) {
    const unsigned G = gridDim.x * gridDim.y * gridDim.z;
    unsigned sum, cnt, mine, sp = 0u;
    for (;;) {
        sum = 0u; cnt = 0u; mine = 0u;
#pragma unroll
        for (unsigned j = 0; j < 16; ++j) { const unsigned c = xb_ld(&bar[XB_XCNT(j)]); sum += c; cnt += (c > 0u) ? 1u : 0u; mine = (j == x) ? c : mine; }
        if (sum == G) break;
        __builtin_amdgcn_s_sleep(1);
        if ((++sp & 255u) == 0u) { if (xb_ld(&bar[XB_TMO])) break; if (sp > XB_SPIN_CAP) { atomicAdd(&bar[XB_TMO], 1u); break; } }
    }
    nloc = mine > 0u ? mine : 1u; nx = cnt > 0u ? cnt : 1u;
}
__device__ __forceinline__ void xcd_barrier(const XcdBarrier& b) {
    asm volatile("s_waitcnt vmcnt(0)" ::: "memory");
    __syncthreads();
    if (threadIdx.x == 0) {
        unsigned* bar = b.bar;
        __builtin_amdgcn_s_waitcnt(0);
        unsigned nloc = b.st[0], nx = b.st[1];
        if (nloc == 0u) { xcd_barrier_complete(bar, b.x, nloc, nx); b.st[0] = nloc; b.st[1] = nx; }
        const unsigned old = xb_add(&bar[XB_XSUB(b.x)], 1u);
        const unsigned gen = old / nloc;
        if (old + 1u == (gen + 1u) * nloc) {
            __builtin_amdgcn_fence(__ATOMIC_RELEASE, "agent");
            asm volatile("s_waitcnt vmcnt(0)" ::: "memory");
            const unsigned og = xb_add(&bar[XB_TOP], 1u);
            const unsigned tg = og / nx;
            if (og + 1u == (tg + 1u) * nx) xb_add(&bar[XB_TOPGEN], 1u);
            else XB_SPIN(xb_ld(&bar[XB_TOPGEN]) == tg, bar);
            __builtin_amdgcn_fence(__ATOMIC_ACQUIRE, "agent");
            xb_add(&bar[XB_XGEN(b.x)], 1u);
            asm volatile("s_waitcnt vmcnt(0)" ::: "memory");
        } else {
            XB_SPIN(xb_ld(&bar[XB_XGEN(b.x)]) == gen, bar);
            __builtin_amdgcn_fence(__ATOMIC_ACQUIRE, "agent");
            asm volatile("s_waitcnt vmcnt(0)" ::: "memory");
        }
    }
    __syncthreads();
}

__device__ __forceinline__ float wave_sum(float v) {
#pragma unroll
    for (int o = 1; o < 64; o <<= 1) v += __shfl_xor(v, o);
    return v;
}
__device__ __forceinline__ float wave_max(float v) {
#pragma unroll
    for (int o = 1; o < 64; o <<= 1) v = fmaxf(v, __shfl_xor(v, o));
    return v;
}
__device__ __forceinline__ void transpose_item(const float* W, int K, int N, bf16* WT, int drow, LAS float* scr, int k0, int n0, int lane) {
#pragma unroll 8
    for (int i = 0; i < 32; ++i) { const int kk = 2 * i + (lane >> 5); scr[kk * 33 + (lane & 31)] = W[(size_t)(k0 + kk) * N + n0 + (lane & 31)]; }
    LDS_WAIT(); asm volatile("" ::: "memory");
    const int c = lane & 7;
#pragma unroll
    for (int j = 0; j < 4; ++j) { const int n = (lane >> 3) + 8 * j; const LAS float* s = scr + (8 * c) * 33 + n;
        v4u o; o.x = pk2(s[0 * 33], s[1 * 33]); o.y = pk2(s[2 * 33], s[3 * 33]); o.z = pk2(s[4 * 33], s[5 * 33]); o.w = pk2(s[6 * 33], s[7 * 33]);
        *(GAS v4u*)(WT + (size_t)(drow + n) * K + k0 + 8 * c) = o; }
    LDS_WAIT(); asm volatile("" ::: "memory");
}
__device__ __forceinline__ void norm_mod(f32x4 (&v)[4], const float* g, const float* sh, const float* sc, int lane, float eps) {
    float ss = 0.f;
#pragma unroll
    for (int j = 0; j < 4; ++j) ss += (v[j].x * v[j].x + v[j].y * v[j].y) + (v[j].z * v[j].z + v[j].w * v[j].w);
    const float r = 1.0f / sqrtf(wave_sum(ss) * (1.f / D) + eps);
#pragma unroll
    for (int j = 0; j < 4; ++j) {
        const int c0 = 4 * lane + 256 * j;
        const f32x4 gg = *(const f32x4*)(g + c0);
        v[j] = v[j] * r * gg;
        if (sc) { const f32x4 s1 = *(const f32x4*)(sc + c0), s0 = *(const f32x4*)(sh + c0); v[j] = v[j] * (1.f + s1) + s0; }
    }
}
__device__ __forceinline__ void load_mod(f32x4 (&g)[4], f32x4 (&s1)[4], f32x4 (&s0)[4], const float* gp, const float* sh, const float* sc, int lane) {
#pragma unroll
    for (int j = 0; j < 4; ++j) { const int c0 = 4 * lane + 256 * j; g[j] = *(const f32x4*)(gp + c0);
        if (sc) { s1[j] = *(const f32x4*)(sc + c0) + 1.f; s0[j] = *(const f32x4*)(sh + c0); } else { s1[j] = (f32x4){1.f, 1.f, 1.f, 1.f}; s0[j] = (f32x4){0.f, 0.f, 0.f, 0.f}; } }
}
__device__ __forceinline__ void norm_apply(f32x4 (&v)[4], const f32x4 (&g)[4], const f32x4 (&s1)[4], const f32x4 (&s0)[4], float eps) {
    float ss = 0.f;
#pragma unroll
    for (int j = 0; j < 4; ++j) ss += (v[j].x * v[j].x + v[j].y * v[j].y) + (v[j].z * v[j].z + v[j].w * v[j].w);
    const float r = 1.0f / sqrtf(wave_sum(ss) * (1.f / D) + eps);
#pragma unroll
    for (int j = 0; j < 4; ++j) v[j] = (v[j] * r * g[j]) * s1[j] + s0[j];
}
__device__ __forceinline__ void store_row_bf16(bf16* orow, const f32x4 (&v)[4], int lane) {
    GAS unsigned long long* o8 = (GAS unsigned long long*)orow + lane;
#pragma unroll
    for (int j = 0; j < 4; ++j) o8[64 * j] = (unsigned long long)pk2(v[j].x, v[j].y) | ((unsigned long long)pk2(v[j].z, v[j].w) << 32);
}
__device__ __forceinline__ float dot8(const v4u kv, const LAS float* q) {
    return bf_lo(kv.x) * q[0] + bf_hi(kv.x) * q[1] + bf_lo(kv.y) * q[2] + bf_hi(kv.y) * q[3] + bf_lo(kv.z) * q[4] + bf_hi(kv.z) * q[5] + bf_lo(kv.w) * q[6] + bf_hi(kv.w) * q[7];
}


namespace att {
typedef short bf16x8 __attribute__((ext_vector_type(8)));
typedef short s16x4 __attribute__((ext_vector_type(4)));
typedef short v4i16_t __attribute__((ext_vector_type(4)));
typedef float f32x16 __attribute__((ext_vector_type(16)));
typedef unsigned u32x4 __attribute__((ext_vector_type(4)));
typedef float f32x2_t __attribute__((ext_vector_type(2))); typedef __bf16 bf16x2_t __attribute__((ext_vector_type(2)));
typedef LAS const unsigned char* lds_cptr;
__device__ __forceinline__ int crow(int r, int hi) { return (r & 3) + 8 * (r >> 2) + 4 * hi; }
__device__ __forceinline__ int kperm(int i) { return 16 * ((i >> 2) & 1) + (i & 3) + 4 * (i >> 3); }
__device__ __forceinline__ void glds16(const void* gsrc, unsigned lds_dst) { unsigned keep;
    asm volatile("s_mov_b32 %0, m0\n\ts_mov_b32 m0, %2\n\ts_nop 0\n\tglobal_load_lds_dwordx4 %1, off\n\ts_mov_b32 m0, %0" : "=&s"(keep) : "v"(gsrc), "s"(lds_dst) : "memory"); }
__device__ __forceinline__ unsigned cvtpk_s(float lo, float hi) { f32x2_t v = {lo, hi}; bf16x2_t b = __builtin_convertvector(v, bf16x2_t); return __builtin_bit_cast(unsigned, b); }
__device__ __forceinline__ s16x4 vtr(lds_cptr p) { return __builtin_bit_cast(s16x4, __builtin_amdgcn_ds_read_tr16_b64_v4i16((LAS v4i16_t*)p)); }
__device__ __forceinline__ float partner(float v, int hi) { auto rr = __builtin_amdgcn_permlane32_swap(__float_as_uint(v), __float_as_uint(v), false, false); return __uint_as_float(hi ? rr[0] : rr[1]); }
#define ATT_WAIT_BAR(N) asm volatile("s_waitcnt vmcnt(" #N ") lgkmcnt(0)\n\ts_barrier" ::: "memory")
#define ATT_PACK(P, B) (u32x4){cvtpk_s(P[B], P[B + 1]), cvtpk_s(P[B + 2], P[B + 3]), cvtpk_s(P[B + 4], P[B + 5]), cvtpk_s(P[B + 6], P[B + 7])}

__device__ __forceinline__ float max3f(float a, float b, float c) { float r; asm("v_max3_f32 %0, %1, %2, %3" : "=v"(r) : "v"(a), "v"(b), "v"(c)); return r; }
__device__ __forceinline__ float max2f(float a, float b) { float r; asm("v_max_f32_e32 %0, %1, %2" : "=v"(r) : "v"(a), "v"(b)); return r; }
template <int PV_>
__device__ __forceinline__ void diff_unit(int b, int h, int qb, const bf16* Q, const bf16* K, const bf16* V, bf16* O, LAS unsigned char* shm, float lam, const float* subg, int tid) {
    const int lane = tid & 63, r32 = lane & 31, hi = lane >> 5; const int wid = __builtin_amdgcn_readfirstlane(tid >> 6);
    const int m = wid >> 2, rg = wid & 3;
    const long rowbase = (long)b * SEQ; const int q0 = qb * 128;
    float slope2_ = __builtin_amdgcn_exp2f(-(float)(h + 1)) * LOG2E; asm volatile("" : "+v"(slope2_));
    const float slope2 = slope2_;
    const unsigned lds0 = (unsigned)(uintptr_t)shm;
    LAS float* wsf = (LAS float*)(shm + 131072 + wid * 256);
    const bf16* dsrc; long dstep; unsigned ddst;
    if (wid < 4) { const int key = 32 * (lane >> 5) + kperm(lane & 31); dsrc = K + (rowbase + key) * D + h * 128 + (wid >> 1) * 64 + 32 * (wid & 1); dstep = 8; ddst = ((wid >> 1) * 8 + 4 * (wid & 1)) * 1024; }
    else { dsrc = V + (rowbase + (lane >> 2)) * D + h * 128 + (wid - 4) * 32 + (lane & 3) * 8; dstep = 16 * D; ddst = 16384 + (wid - 4) * 4096; }
#define DIFF_DMA(j, slot) do { if (!(PV_ & 1)) { const unsigned d_ = (unsigned)__builtin_amdgcn_readfirstlane(lds0 + (slot) * 32768 + ddst); const bf16* s_ = dsrc + (long)(j) * 64 * D; \
        glds16(s_, d_); glds16(s_ + dstep, d_ + 1024); glds16(s_ + 2 * dstep, d_ + 2048); glds16(s_ + 3 * dstep, d_ + 3072); } } while (0)
    const int nt = 2 * qb + 2, jw = 2 * qb + (rg >> 1);
    DIFF_DMA(0, 0); DIFF_DMA(1, 1); if (nt > 2) DIFF_DMA(2, 2);
    bf16x8 qr[4];
    { const bf16* Qw = Q + (rowbase + q0 + 32 * rg) * D + h * 128 + m * 64;
#pragma unroll
      for (int d0 = 0; d0 < 4; ++d0) qr[d0] = *reinterpret_cast<const bf16x8*>(&Qw[(long)r32 * D + d0 * 16 + hi * 8]); }
    float mhat = 0.f, l_reg = 0.f; f32x16 o[4];
#pragma unroll
    for (int e = 0; e < 4; ++e) o[e] = f32x16{};
    f32x16 srv;
#pragma unroll
    for (int r = 0; r < 16; ++r) srv[r] = slope2 * (float)r;
    const float tqf = (float)(q0 + 32 * rg + r32);
    const lds_cptr kp0 = (lds_cptr)shm + m * 8192 + hi * 1024 + r32 * 16;
    const lds_cptr vp0 = (lds_cptr)shm + 16384 + hi * 1024 + ((lane & 15) >> 2) * 64 + ((lane >> 4) & 1) * 32 + (lane & 3) * 8;
    u32x4 pw0, pw1, pw2, pw3;
    int slot = 0, slot2 = 3;
    if (nt > 2) asm volatile("s_waitcnt vmcnt(12)\n\ts_barrier" ::: "memory"); else asm volatile("s_waitcnt vmcnt(8)\n\ts_barrier" ::: "memory");
    if (m == 1) asm volatile("s_barrier" ::: "memory");
    for (int j = 0; j < ((PV_ & 8) ? 0 : nt); ++j) {
        if (m == 1 && j + 3 < nt) DIFF_DMA(j + 3, slot2);
        if (j <= jw) {
            f32x16 p0, p1; bf16x8 kf[8];
            { const lds_cptr kp = kp0 + slot * 32768;
#pragma unroll
              for (int d0 = 0; d0 < 4; ++d0) { kf[2 * d0] = *(const LAS bf16x8*)(kp + d0 * 2048); kf[2 * d0 + 1] = *(const LAS bf16x8*)(kp + d0 * 2048 + 512); } }
            __builtin_amdgcn_sched_barrier(0);
            const float base0 = (float)(64 * j + 16 * hi) - tqf;
            if (j < jw) { const float t0 = __builtin_fmaf(slope2, base0, -mhat), t1 = __builtin_fmaf(slope2, 32.f, t0);
#pragma unroll
                for (int r = 0; r < 16; ++r) { p0[r] = srv[r] + t0; p1[r] = srv[r] + t1; } }
            else {
#pragma unroll
                for (int r = 0; r < 16; ++r) { const float d0 = base0 + (float)r; p0[r] = __builtin_fmaf(-slope2, __builtin_fabsf(d0), -mhat); p1[r] = __builtin_fmaf(-slope2, __builtin_fabsf(d0 + 32.f), -mhat); } }
            asm volatile("s_waitcnt lgkmcnt(0)" ::: "memory"); __builtin_amdgcn_sched_barrier(0);
#pragma unroll
            for (int d0 = 0; d0 < 4; ++d0) { p0 = __builtin_amdgcn_mfma_f32_32x32x16_bf16(kf[2 * d0], qr[d0], p0, 0, 0, 0); p1 = __builtin_amdgcn_mfma_f32_32x32x16_bf16(kf[2 * d0 + 1], qr[d0], p1, 0, 0, 0); }
            asm volatile("s_nop 15\n\ts_nop 7" : "+v"(p0), "+v"(p1));
            if (!(PV_ & 2)) {
            float rm;
            { float a = max3f(p0[0], p0[1], p1[0]), c = max3f(p0[2], p0[3], p1[1]); a = max3f(a, p1[2], p1[3]);
#pragma unroll
              for (int r = 4; r < 16; r += 4) { a = max3f(a, p0[r], p0[r + 1]); c = max3f(c, p0[r + 2], p0[r + 3]); a = max3f(a, p1[r], p1[r + 1]); c = max3f(c, p1[r + 2], p1[r + 3]); }
              rm = max2f(a, c); auto rr = __builtin_amdgcn_permlane32_swap(__float_as_uint(rm), __float_as_uint(rm), false, false); rm = max2f(__uint_as_float(rr[0]), __uint_as_float(rr[1])); }
            if (j == 0) { mhat = rm;
#pragma unroll
                for (int r = 0; r < 16; ++r) { p0[r] -= rm; p1[r] -= rm; } }
            else if (__any(rm > 8.f)) {
                const float dl = __builtin_fmaxf(rm, 0.f); mhat += dl;
#pragma unroll
                for (int r = 0; r < 16; ++r) { p0[r] -= dl; p1[r] -= dl; }
                const float f = __builtin_amdgcn_exp2f(-dl); l_reg *= f; if (hi == 0) wsf[r32] = f;
                asm volatile("s_waitcnt lgkmcnt(0)" ::: "memory");
#pragma unroll
                for (int e = 0; e < 4; ++e)
#pragma unroll
                    for (int r = 0; r < 16; ++r) o[e][r] *= wsf[crow(r, hi)];
            }
            float sacc = 0.f;
#pragma unroll
            for (int r = 0; r < 16; ++r) { p0[r] = __builtin_amdgcn_exp2f(p0[r]); p1[r] = __builtin_amdgcn_exp2f(p1[r]); sacc += p0[r] + p1[r]; }
            l_reg += sacc;
            }
            pw0 = ATT_PACK(p0, 0); pw1 = ATT_PACK(p0, 8); pw2 = ATT_PACK(p1, 0); pw3 = ATT_PACK(p1, 8);
        }
        if (m == 1 && j + 1 < nt) { if (j + 3 < nt) asm volatile("s_waitcnt vmcnt(8)" ::: "memory"); else if (j + 2 < nt) asm volatile("s_waitcnt vmcnt(4)" ::: "memory"); else asm volatile("s_waitcnt vmcnt(0)" ::: "memory"); }
        asm volatile("s_waitcnt lgkmcnt(0)\n\ts_barrier" ::: "memory");
        if (m == 0 && j + 3 < nt) DIFF_DMA(j + 3, slot2);
        if (j <= jw && !(PV_ & 4)) {
            const lds_cptr vp = vp0 + slot * 32768;
#pragma unroll
            for (int e = 0; e < 4; ++e) {
                s16x4 vl[4], vh[4];
#pragma unroll
                for (int ks = 0; ks < 4; ++ks) { vl[ks] = vtr(vp + e * 4096 + (ks >> 1) * 2048 + (ks & 1) * 512); vh[ks] = vtr(vp + e * 4096 + (ks >> 1) * 2048 + (ks & 1) * 512 + 256); }
                asm volatile("s_waitcnt lgkmcnt(0)" ::: "memory"); __builtin_amdgcn_sched_barrier(0);
#define DIFF_PV(ks, PW) o[e] = __builtin_amdgcn_mfma_f32_32x32x16_bf16(__builtin_bit_cast(bf16x8, PW), (bf16x8){vl[ks][0], vl[ks][1], vl[ks][2], vl[ks][3], vh[ks][0], vh[ks][1], vh[ks][2], vh[ks][3]}, o[e], 0, 0, 0)
                DIFF_PV(0, pw0); DIFF_PV(1, pw1); DIFF_PV(2, pw2); DIFF_PV(3, pw3);
#undef DIFF_PV
            }
        }
        if (m == 0 && j + 1 < nt) { if (j + 3 < nt) asm volatile("s_waitcnt vmcnt(8)" ::: "memory"); else if (j + 2 < nt) asm volatile("s_waitcnt vmcnt(4)" ::: "memory"); else asm volatile("s_waitcnt vmcnt(0)" ::: "memory"); }
        asm volatile("s_waitcnt lgkmcnt(0)\n\ts_barrier" ::: "memory");
        slot = (slot + 1) & 3; slot2 = (slot2 + 1) & 3;
    }
    if (m == 0) asm volatile("s_barrier" ::: "memory");
    l_reg += partner(l_reg, hi);
    { const float rl = (m == 1 ? lam : 1.f) / l_reg; if (hi == 0) wsf[32 + r32] = rl; }
    asm volatile("s_waitcnt lgkmcnt(0)" ::: "memory");
    float rli[16];
#pragma unroll
    for (int r = 0; r < 16; ++r) rli[r] = wsf[32 + crow(r, hi)];
    ATT_WAIT_BAR(0);
    LAS float* S = (LAS float*)(shm + rg * 16384);
    if (m == 1) {
#pragma unroll
        for (int e = 0; e < 4; ++e)
#pragma unroll
            for (int r = 0; r < 16; ++r) S[crow(r, hi) * 128 + e * 32 + r32] = o[e][r] * rli[r];
    }
    ATT_WAIT_BAR(0);
    if (m == 0) {
#pragma unroll
        for (int e = 0; e < 4; ++e)
#pragma unroll
            for (int r = 0; r < 16; ++r) { const int ix = crow(r, hi) * 128 + e * 32 + r32; S[ix] = o[e][r] * rli[r] - S[ix]; }
    }
    ATT_WAIT_BAR(0);
    { const int row = 16 * m + (lane >> 2), qq = lane & 3;
      const LAS f32x4* sp = (const LAS f32x4*)(S + row * 128 + qq * 32);
      f32x4 v[8]; float ss = 0.f;
#pragma unroll
      for (int i = 0; i < 8; ++i) { v[i] = sp[i]; ss += (v[i].x * v[i].x + v[i].y * v[i].y) + (v[i].z * v[i].z + v[i].w * v[i].w); }
      ss += __shfl_xor(ss, 1); ss += __shfl_xor(ss, 2);
      const float rn = 0.8f / sqrtf(ss * (1.f / 128.f) + 1e-5f);
      bf16* op = O + (rowbase + q0 + 32 * rg + row) * D + h * 128 + qq * 32;
#pragma unroll
      for (int i = 0; i < 4; ++i) { const f32x4 g0 = *(const f32x4*)(subg + qq * 32 + 8 * i), g1 = *(const f32x4*)(subg + qq * 32 + 8 * i + 4); const f32x4 a = v[2 * i] * rn * g0, c = v[2 * i + 1] * rn * g1;
          *(u32x4*)(op + 8 * i) = (u32x4){cvtpk_s(a.x, a.y), cvtpk_s(a.z, a.w), cvtpk_s(c.x, c.y), cvtpk_s(c.z, c.w)}; } }
    ATT_WAIT_BAR(0);
#undef DIFF_DMA
}

__device__ __forceinline__ void sb_unit(int b, int h, int qb, const bf16* Q, const bf16* K, const bf16* V, bf16* O, LAS unsigned char* shm, int tid) {
    const int lane = tid & 63, r32 = lane & 31, hi = lane >> 5; const int wid = __builtin_amdgcn_readfirstlane(tid >> 6);
    const long rowbase = (long)b * SEQ; const int q0 = qb * 256;
    const unsigned lds0 = (unsigned)(uintptr_t)shm;
    volatile LAS unsigned* flags = (volatile LAS unsigned*)(shm + 65536);
    const bf16* ksrc = K + (rowbase + 32 * (lane >> 5) + kperm(lane & 31)) * D + h * 64 + wid * 8;
    const bf16* vsrc = V + (rowbase + 16 * (wid & 3) + (lane >> 2)) * D + h * 64 + (wid >> 2) * 32 + (lane & 3) * 8;
    const unsigned kdst = lds0 + wid * 1024, vdst = lds0 + 8192 + wid * 1024;
#define SB_DMA(j, slot) do { glds16(ksrc + (long)(j) * 64 * D, (unsigned)__builtin_amdgcn_readfirstlane(kdst + (slot) * 16384)); glds16(vsrc + (long)(j) * 64 * D, (unsigned)__builtin_amdgcn_readfirstlane(vdst + (slot) * 16384)); } while (0)
    const int jmax = 4 * qb + 3, jw = 4 * qb + (wid >> 1);
    SB_DMA(jmax, 0);
    if (lane == 0) flags[wid] = 0u;
    bf16x8 qr[4];
    { const bf16* Qw = Q + (rowbase + q0 + 32 * wid) * D + h * 64;
#pragma unroll
      for (int d0 = 0; d0 < 4; ++d0) qr[d0] = *reinterpret_cast<const bf16x8*>(&Qw[(long)r32 * D + d0 * 16 + hi * 8]); }
    float R = 1.f; f32x16 o[2]; o[0] = f32x16{}; o[1] = f32x16{};
    const int tloc0 = 32 * (wid & 1) + r32 - 16 * hi;
    const lds_cptr kp0 = (lds_cptr)shm + hi * 1024 + r32 * 16;
    const lds_cptr vp0 = (lds_cptr)shm + 8192 + hi * 1024 + ((lane & 15) >> 2) * 64 + ((lane >> 4) & 1) * 32 + (lane & 3) * 8;
    bool mydone = false;
    for (int it = 0; it <= jmax; ++it) {
        const int j = jmax - it, slot = it & 1;
        ATT_WAIT_BAR(0);
        { unsigned all = 1u;
#pragma unroll
          for (int w = 0; w < NWAVES; ++w) all &= flags[w];
          if (all) break; }
        if (j > 0) SB_DMA(j - 1, slot ^ 1);
        if (j <= jw && !mydone) {
            f32x16 p0 = f32x16{}, p1 = f32x16{};
            const lds_cptr kp = kp0 + slot * 16384;
#pragma unroll
            for (int d0 = 0; d0 < 4; ++d0) {
                const bf16x8 k0 = *(const LAS bf16x8*)(kp + d0 * 2048), k1 = *(const LAS bf16x8*)(kp + d0 * 2048 + 512);
                p0 = __builtin_amdgcn_mfma_f32_32x32x16_bf16(k0, qr[d0], p0, 0, 0, 0); p1 = __builtin_amdgcn_mfma_f32_32x32x16_bf16(k1, qr[d0], p1, 0, 0, 0);
            }
            if (j == jw) {
#pragma unroll
                for (int r = 0; r < 16; ++r) { if (r >= tloc0) p0[r] = -INFINITY; if (r + 32 >= tloc0) p1[r] = -INFINITY; }
            }
            float TA = 1.f, TB = 1.f;
#pragma unroll
            for (int r = 0; r < 16; ++r) { p0[r] = __builtin_amdgcn_rcpf(1.f + __builtin_amdgcn_exp2f(p0[r])); p1[r] = __builtin_amdgcn_rcpf(1.f + __builtin_amdgcn_exp2f(p1[r])); TA *= p0[r]; TB *= p1[r]; }
            const float TAp = partner(TA, hi), TBp = partner(TB, hi);
            const float preB = hi ? R : R * TBp;
            const float preA = hi ? (R * TB) * TBp : ((R * TBp) * TB) * TAp;
            R = (((R * TA) * TB) * TAp) * TBp;
            { float e = preB;
#pragma unroll
              for (int r = 15; r >= 0; --r) { const float f = p1[r]; p1[r] = (1.f - f) * e; e *= f; }
              e = preA;
#pragma unroll
              for (int r = 15; r >= 0; --r) { const float f = p0[r]; p0[r] = (1.f - f) * e; e *= f; } }
            const u32x4 pw0 = ATT_PACK(p0, 0), pw1 = ATT_PACK(p0, 8), pw2 = ATT_PACK(p1, 0), pw3 = ATT_PACK(p1, 8);
            const lds_cptr vp = vp0 + slot * 16384;
#pragma unroll
            for (int e = 0; e < 2; ++e) {
#define SB_PV(ks, PW) do { const s16x4 lo_ = vtr(vp + e * 4096 + ((ks) >> 1) * 2048 + ((ks) & 1) * 512), hi_ = vtr(vp + e * 4096 + ((ks) >> 1) * 2048 + ((ks) & 1) * 512 + 256); \
                const bf16x8 vb_ = (bf16x8){lo_[0], lo_[1], lo_[2], lo_[3], hi_[0], hi_[1], hi_[2], hi_[3]}; \
                o[e] = __builtin_amdgcn_mfma_f32_32x32x16_bf16(__builtin_bit_cast(bf16x8, PW), vb_, o[e], 0, 0, 0); } while (0)
                SB_PV(0, pw0); SB_PV(1, pw1); SB_PV(2, pw2); SB_PV(3, pw3);
#undef SB_PV
            }
            mydone = __all(R < 1e-30f);
            if (mydone && lane == 0) flags[wid] = 1u;
        }
    }
    ATT_WAIT_BAR(0);
    { bf16* Ow = O + (rowbase + q0 + 32 * wid) * D + h * 64;
      LAS bf16* stg = (LAS bf16*)(shm + 32768 + wid * 4096);
#pragma unroll
      for (int r = 0; r < 16; ++r) { const int orow = crow(r, hi);
#pragma unroll
          for (int e = 0; e < 2; ++e) stg[orow * 64 + e * 32 + r32] = (bf16)(cvtpk_s(o[e][r], 0.f) & 0xffffu); }
      asm volatile("s_waitcnt lgkmcnt(0)" ::: "memory");
#pragma unroll
      for (int i = 0; i < 4; ++i) { const int row = i * 8 + (lane >> 3), ch = lane & 7; const u32x4 v = *(const LAS u32x4*)(stg + row * 64 + ch * 8); *(u32x4*)(Ow + (long)row * D + ch * 8) = v; } }
    ATT_WAIT_BAR(0);
#undef SB_DMA
}
}

struct Args {
    const float* in[23]; float* out; unsigned char* ws; int ph_lo, ph_hi;
};

__global__ void __launch_bounds__(NTHR, 2) fwd(Args args) {
    extern __shared__ __attribute__((aligned(16))) unsigned char lds_raw[];
    LAS unsigned char* lds = (LAS unsigned char*)lds_raw;
    volatile LAS unsigned* MISC = (volatile LAS unsigned*)(lds + MISC_OFF);
    const int G = gridDim.x, bx = blockIdx.x;
    const int wave0 = __builtin_amdgcn_readfirstlane(threadIdx.x >> 6);
#define PHASE_IDS() int lane_; asm volatile("v_mbcnt_lo_u32_b32 %0, -1, 0\n\tv_mbcnt_hi_u32_b32 %0, -1, %0" : "=v"(lane_)); const int lane = lane_, wave = wave0, tid = wave0 * 64 + lane_; const int gw = vcu * NWAVES + wave; (void)lane; (void)gw; (void)tid
    const int vcu = (G % 8 == 0) ? (bx % 8) * (G / 8) + bx / 8 : bx;
    unsigned char* ws = args.ws;
    gu32* ctl = (gu32*)(ws + WS_CTL);
    for (int u = threadIdx.x; u < (LDS_BYTES - MISC_OFF) / 4; u += NTHR) ((LAS unsigned*)(lds + MISC_OFF))[u] = 0u;
    __syncthreads();
    XcdBarrier bar; bar.bar = (unsigned*)ctl + CW_BAR; bar.x = 0; bar.st = nullptr;
    if (MK_ONE_LAUNCH) bar = xcd_barrier_post((unsigned*)ctl + CW_BAR, MISC + 8);
#define GRID_BAR() do { if (MK_ONE_LAUNCH) xcd_barrier(bar); } while (0)
    const int lo = args.ph_lo, hi = args.ph_hi;
#define IN(k) (lo <= (k) && (k) < hi)
#define BOTH(k) (IN(k) && IN((k) + 1))
    const float* x_in = args.in[0]; const float* c_in = args.in[1];
    const float* norm1_g = args.in[2]; const float* norm2_g = args.in[3];
    const float* ada_w = args.in[4]; const float* ada_b = args.in[5];
    float* xs = args.out;
    float* mod = (float*)(ws + WS_MOD);
    bf16* XN = (bf16*)(ws + WS_XN); bf16* Qb = (bf16*)(ws + WS_Q); bf16* Kb = (bf16*)(ws + WS_K); bf16* Vb = (bf16*)(ws + WS_V); bf16* Ob = (bf16*)(ws + WS_O);
    bf16* Hm = (bf16*)(ws + WS_HM); bf16* Yd = (bf16*)(ws + WS_YD);
    const int NGW = G * NWAVES;

    if (IN(0)) {
            PHASE_IDS();
        if (bx < 192) {
            LAS float* cond = (LAS float*)lds; LAS float* red = (LAS float*)(lds + 32768);
            const int l = bx / 96, j0 = (bx % 96) * 64;
            for (int i = tid; i < BATCH * D; i += NTHR) { const float v = c_in[i]; cond[i] = v / (1.f + __expf(-v)); }
            __syncthreads();
            float acc[BATCH];
#pragma unroll
            for (int b = 0; b < BATCH; ++b) acc[b] = 0.f;
            const float* W = ada_w + (size_t)l * D * 6 * D + j0 + lane;
#pragma unroll 8
            for (int k = wave * 128; k < wave * 128 + 128; ++k) {
                const float w = W[(size_t)k * 6 * D];
#pragma unroll
                for (int b = 0; b < BATCH; ++b) acc[b] += cond[b * D + k] * w;
            }
#pragma unroll
            for (int b = 0; b < BATCH; ++b) red[(wave * BATCH + b) * 64 + lane] = acc[b];
            __syncthreads();
            { const int b = tid >> 6, j = tid & 63; float s = ada_b[(size_t)l * 6 * D + j0 + j];
#pragma unroll
              for (int w = 0; w < NWAVES; ++w) s += red[(w * BATCH + b) * 64 + j];
              mod[((size_t)l * BATCH + b) * 6 * D + j0 + j] = s; }
        }
        if (BOTH(0)) GRID_BAR();
    }

    if (IN(1)) {
            PHASE_IDS();
for (int rep_ = 0; rep_ < NREP(0, true); ++rep_) {
        LAS float* scr = (LAS float*)(lds + wave * 16384);
        constexpr int I_IN = 16 * 96, I_OUT = 16 * 32, I_G = 32 * 256, I_D = 32 * 256, I_LAYER = I_IN + I_OUT + 2 * I_G + I_D;
        for (int it = gw; it < DEPTH * I_LAYER; it += NGW) {
            const int l = it / I_LAYER; int r = it % I_LAYER;
            unsigned char* wl = ws + WS_W + (size_t)l * W_LAYER;
            if (r < I_IN) { const float* W = args.in[l == 0 ? 6 : 13]; transpose_item(W, D, 3 * D, (bf16*)(wl + W_IN), 32 * (r % 96), scr, 64 * (r / 96), 32 * (r % 96), lane); continue; } r -= I_IN;
            if (r < I_OUT) { const float* W = args.in[l == 0 ? 7 : 14]; transpose_item(W, D, D, (bf16*)(wl + W_OUT), 32 * (r % 32), scr, 64 * (r / 32), 32 * (r % 32), lane); continue; } r -= I_OUT;
            if (r < 2 * I_G) { const int up = r / I_G; r %= I_G; const int e = r / 256, rr = r % 256, n0 = 32 * (rr % 16);
                const float* W = args.in[up ? 20 : 19] + ((size_t)l * NE + e) * D * FH;
                transpose_item(W, D, FH, (bf16*)(wl + W_GU) + (size_t)e * D * D, (n0 / 128) * 256 + (n0 % 128) + up * 128, scr, 64 * (rr / 16), n0, lane); continue; } r -= 2 * I_G;
            { const int e = r / 256, rr = r % 256; const float* W = args.in[21] + ((size_t)l * NE + e) * FH * D;
              transpose_item(W, FH, D, (bf16*)(wl + W_DN) + (size_t)e * D * FH, 32 * (rr % 32), scr, 64 * (rr / 32), 32 * (rr % 32), lane); }
        }
        { float* rt = (float*)(ws + WS_RT);
          for (int i = gw * 64 + lane; i < DEPTH * 36 * D; i += NGW * 64) { const int l = i / (36 * D), j = (i / D) % 36, k = i % D;
              rt[i] = (j < 4) ? args.in[15][((size_t)l * D + k) * NG + j] : args.in[17][((size_t)l * D + k) * NE + (j - 4)]; } }
        for (int m0 = gw * 4; m0 < NTOK; m0 += NGW * 4) {
            const float* mb = mod + (size_t)(m0 / SEQ) * 6 * D;
            f32x4 g[4], s1[4], s0[4]; load_mod(g, s1, s0, norm1_g, mb, mb + D, lane);
            f32x4 v[4][4];
#pragma unroll
            for (int i = 0; i < 4; ++i)
#pragma unroll
                for (int j = 0; j < 4; ++j) v[i][j] = ((const GAS f32x4*)(x_in + (size_t)(m0 + i) * D) + lane)[64 * j];
#pragma unroll
            for (int i = 0; i < 4; ++i) { norm_apply(v[i], g, s1, s0, 1e-6f); store_row_bf16(XN + (size_t)(m0 + i) * D, v[i], lane); }
        }
}
                    if (BOTH(1)) GRID_BAR();
    }

#pragma unroll 1
    for (int l = 0; l < DEPTH; ++l) {
        const int pb = 2 + 8 * l;
        unsigned char* wl = ws + WS_W + (size_t)l * W_LAYER;
        const float* modl = mod + (size_t)l * BATCH * 6 * D;
        int* eid = (int*)(ws + WS_EID + l * LSTRIDE); float* ew = (float*)(ws + WS_EW + l * LSTRIDE); int* hist = (int*)(ws + WS_HIST + l * LSTRIDE);
        int* sop = (int*)(ws + WS_SOP + l * LSTRIDE); int* stok = (int*)(ws + WS_STOK + l * LSTRIDE); int* tiles = (int*)(ws + WS_TILES + l * LSTRIDE);

        if (IN(pb + 0)) {
            PHASE_IDS();
for (int rep_ = 0; rep_ < NREP(1, true); ++rep_) {
            pg8::StaticOrder S; S.init(NTOK, 3 * D, G, bx, (const bf16*)(wl + W_IN));
            pg8::EpiBf16 E{Qb, D, D, (size_t)(WS_K - WS_Q) / 2, C2};
            pg8::gemm_phase<pg8::EpiBf16, pg8::StaticOrder, false>(lds, XN, D, nullptr, S, E, tid);
}
                        if (BOTH(pb + 0)) GRID_BAR();
        }
        if (IN(pb + 1)) {
            PHASE_IDS();
for (int rep_ = 0; rep_ < ((NREP(2, l == 0) > 1 || NREP(3, l == 1) > 1) ? 2 : 1); ++rep_) {
            if (l == 0) {
                const float* lq1 = args.in[8]; const float* lk1 = args.in[9]; const float* lq2 = args.in[10]; const float* lk2 = args.in[11];
                const float lam = __expf(wave_sum(lq1[lane] * lk1[lane])) - __expf(wave_sum(lq2[lane] * lk2[lane])) + 0.2f;
                const int bh = vcu >> 2, s4 = vcu & 3;
                for (int i = 0; i < 4; ++i) { const int qb = (i == 0) ? s4 : (i == 1) ? 7 - s4 : (i == 2) ? 8 + s4 : 15 - s4;
                    att::diff_unit<0>(bh >> 3, bh & 7, qb, Qb, Kb, Vb, Ob, lds, lam, args.in[12], tid); }
#ifdef DIFF_PROBE
                for (int i = 0; i < 4; ++i) { const int qb = (i == 0) ? s4 : (i == 1) ? 7 - s4 : (i == 2) ? 8 + s4 : 15 - s4;
                    att::diff_unit<DIFF_PROBE>(bh >> 3, bh & 7, qb, Qb, Kb, Vb, (bf16*)(ws + WS_END), lds, lam, args.in[12], tid); }
#endif
            } else {
                const int bh = vcu >> 1, hf = vcu & 1;
                for (int i = 0; i < 4; ++i) { const int qb = (i == 0) ? 2 * hf : (i == 1) ? 7 - 2 * hf : (i == 2) ? 2 * hf + 1 : 6 - 2 * hf;
                    att::sb_unit(bh >> 4, bh & 15, qb, Qb, Kb, Vb, Ob, lds, tid); }
            }
}
                        if (BOTH(pb + 1)) GRID_BAR();
        }
        if (IN(pb + 2)) {
            PHASE_IDS();
for (int rep_ = 0; rep_ < NREP(4, l == 0); ++rep_) {
            pg8::StaticOrder S; S.init(NTOK, D, G, bx, (const bf16*)(wl + W_OUT));
            pg8::EpiResid E{xs, l == 0 ? x_in : xs, D, modl + 2 * D, 6 * D, SEQ};
            pg8::gemm_phase<pg8::EpiResid, pg8::StaticOrder, false>(lds, Ob, D, nullptr, S, E, tid);
}
                        if (BOTH(pb + 2)) GRID_BAR();
        }
        if (IN(pb + 3)) {
            PHASE_IDS();
for (int rep_ = 0; rep_ < NREP(5, true); ++rep_) {
            LAS float* wl_ = (LAS float*)lds;
            LAS int* lhist = (LAS int*)(lds + MISC_OFF + 256);
            const float* rgb = args.in[16] + l * NG; const float* reb = args.in[18] + l * NE;
            { const GAS f32x4* rt4 = (const GAS f32x4*)(ws + WS_RT + (size_t)l * 36 * D * 4);
              for (int i = tid; i < 36 * D / 4; i += NTHR) ((LAS f32x4*)wl_)[i] = rt4[i]; }
            if (tid < NE) lhist[tid] = 0;
            __syncthreads();
            {
                const int tok0 = bx * 64 + wave * 8;
                const float* mb = modl + (size_t)(tok0 / SEQ) * 6 * D;
                f32x4 g[4], s1[4], s0[4]; load_mod(g, s1, s0, norm2_g + l * D, mb + 3 * D, mb + 4 * D, lane);
                f32x4 va[4][4];
#define LOAD4(v, T0) do { _Pragma("unroll") for (int i = 0; i < 4; ++i) _Pragma("unroll") for (int j = 0; j < 4; ++j) v[i][j] = ((const GAS f32x4*)(xs + (size_t)((T0) + i) * D) + lane)[64 * j]; } while (0)
                LOAD4(va, tok0);
#define ROUTE4(v, T0) do { \
                _Pragma("unroll") for (int i = 0; i < 4; ++i) { norm_apply(v[i], g, s1, s0, 1e-6f); store_row_bf16(XN + (size_t)((T0) + i) * D, v[i], lane); } \
                float gl[4][4]; \
                _Pragma("unroll") for (int gq = 0; gq < 4; ++gq) { f32x4 w[4]; _Pragma("unroll") for (int j = 0; j < 4; ++j) w[j] = *(const LAS f32x4*)(wl_ + gq * D + 4 * lane + 256 * j); \
                    _Pragma("unroll") for (int i = 0; i < 4; ++i) { float sx = 0.f; _Pragma("unroll") for (int j = 0; j < 4; ++j) sx += (v[i][j].x * w[j].x + v[i][j].y * w[j].y) + (v[i][j].z * w[j].z + v[i][j].w * w[j].w); gl[i][gq] = sx; } } \
                _Pragma("unroll") for (int i = 0; i < 4; ++i) _Pragma("unroll") for (int gq = 0; gq < 4; ++gq) gl[i][gq] = wave_sum(gl[i][gq]) + rgb[gq]; \
                int gi[4]; float gwt[4]; \
                _Pragma("unroll") for (int i = 0; i < 4; ++i) { int gx = 0; float gm = gl[i][0]; _Pragma("unroll") for (int gq = 1; gq < 4; ++gq) if (gl[i][gq] > gm) { gm = gl[i][gq]; gx = gq; } \
                    float gs = 0.f; _Pragma("unroll") for (int gq = 0; gq < 4; ++gq) gs += __expf(gl[i][gq] - gm); gwt[i] = 1.0f / gs; gi[i] = __builtin_amdgcn_readfirstlane(gx); } \
                float ev[4][8]; \
                _Pragma("unroll") for (int i = 0; i < 4; ++i) _Pragma("unroll") for (int jx = 0; jx < 8; ++jx) { const LAS float* wr_ = wl_ + (4 + gi[i] * 8 + jx) * D; float sx = 0.f; \
                    _Pragma("unroll") for (int j = 0; j < 4; ++j) { const f32x4 w = *(const LAS f32x4*)(wr_ + 4 * lane + 256 * j); sx += (v[i][j].x * w.x + v[i][j].y * w.y) + (v[i][j].z * w.z + v[i][j].w * w.w); } ev[i][jx] = sx; } \
                _Pragma("unroll") for (int i = 0; i < 4; ++i) _Pragma("unroll") for (int jx = 0; jx < 8; ++jx) ev[i][jx] = wave_sum(ev[i][jx]); \
                _Pragma("unroll") for (int i = 0; i < 4; ++i) { float v1 = -INFINITY, v2 = -INFINITY; int i1 = 0, i2 = 0; \
                    _Pragma("unroll") for (int jx = 0; jx < 8; ++jx) { const float e_ = ev[i][jx] + reb[gi[i] * 8 + jx]; if (e_ > v1) { v2 = v1; i2 = i1; v1 = e_; i1 = jx; } else if (e_ > v2) { v2 = e_; i2 = jx; } } \
                    if (lane == 0) { const int tok = (T0) + i; const float e2 = __expf(v2 - v1), den = 1.f / (1.f + e2); \
                        eid[tok * 2] = gi[i] * 8 + i1; eid[tok * 2 + 1] = gi[i] * 8 + i2; ew[tok * 2] = gwt[i] * den; ew[tok * 2 + 1] = gwt[i] * e2 * den; \
                        atomicAdd((int*)(lhist + gi[i] * 8 + i1), 1); atomicAdd((int*)(lhist + gi[i] * 8 + i2), 1); } } } while (0)
                ROUTE4(va, tok0); LOAD4(va, tok0 + 4); ROUTE4(va, tok0 + 4);
#undef ROUTE4
#undef LOAD4
            }
            __syncthreads();
            if (tid < NE) hist[bx * NE + tid] = lhist[tid];
}
                        if (BOTH(pb + 3)) GRID_BAR();
        }
        if (IN(pb + 4)) {
            PHASE_IDS();
            LAS int* tot = (LAS int*)lds; LAS int* bef = tot + 16 * NE; LAS int* pst = bef + 16 * NE; LAS int* tote = pst + 64; LAS int* befe = tote + 32; LAS int* le = befe + 32;
            { const int e = tid & 31, part = tid >> 5; int s = 0, sb = 0;
              for (int w = part * 16; w < part * 16 + 16; ++w) { const int hv = hist[w * NE + e]; s += hv; if (w < bx) sb += hv; }
              tot[part * NE + e] = s; bef[part * NE + e] = sb; }
            __syncthreads();
            if (tid < NE) { int s = 0, sb = 0; for (int p = 0; p < 16; ++p) { s += tot[p * NE + tid]; sb += bef[p * NE + tid]; } tote[tid] = s; befe[tid] = sb; }
            __syncthreads();
            if (tid == 0) { int off = 0; for (int e = 0; e < NE; ++e) { pst[e] = off; off += (tote[e] + 255) / 256 * 256; } pst[NE] = off; }
            if (tid < 128) le[tid] = eid[(bx * 64) * 2 + tid];
            __syncthreads();
            if (tid < 128) { const int e = le[tid]; int rank = 0; for (int q = 0; q < tid; ++q) rank += (le[q] == e) ? 1 : 0;
                const int s = pst[e] + befe[e] + rank; stok[s] = bx * 64 + (tid >> 1); sop[(bx * 64) * 2 + tid] = s; }
            if (bx < NE) { const int e = bx; for (int s = pst[e] + tote[e] + tid; s < pst[e + 1]; s += NTHR) stok[s] = 0; }
            if (bx == NE) { if (tid < NE) { for (int t = pst[tid] / 256; t < pst[tid + 1] / 256; ++t) tiles[1 + t] = tid; } if (tid == 0) tiles[0] = pst[NE] / 256; }
            if (BOTH(pb + 4)) GRID_BAR();
        }
        if (IN(pb + 5)) {
            PHASE_IDS();
for (int rep_ = 0; rep_ < NREP(6, true); ++rep_) {
            LAS int* tl = (LAS int*)(lds + AUX_OFF); LAS int* gidx = tl + 256;
            if (tid < 1 + MAX_TILES) tl[tid] = tiles[tid + vzero()];
            __syncthreads();
            pg8::GroupedOrder S{tl, G, vcu, (const bf16*)(wl + W_GU), (size_t)D * D};
            { pg8::Unit u; for (int i = 0; i < 3 && S.next(i, u); ++i) { if (tid < 256) gidx[i * 256 + tid] = stok[u.pm * 256 + tid]; } }
            __syncthreads();
            pg8::EpiSwiGLU E{Hm, FH};
            pg8::gemm_phase<pg8::EpiSwiGLU, pg8::GroupedOrder, true>(lds, XN, D, gidx, S, E, tid);
}
                        if (BOTH(pb + 5)) GRID_BAR();
        }
        if (IN(pb + 6)) {
            PHASE_IDS();
for (int rep_ = 0; rep_ < NREP(7, true); ++rep_) {
            LAS int* tl = (LAS int*)(lds + AUX_OFF);
            if (tid < 1 + MAX_TILES) tl[tid] = tiles[tid + vzero()];
            __syncthreads();
            pg8::GroupedOrder S{tl, G, vcu, (const bf16*)(wl + W_DN), (size_t)D * FH};
            pg8::EpiBf16 E{Yd, D, 0, 0, 1.f};
            pg8::gemm_phase<pg8::EpiBf16, pg8::GroupedOrder, false>(lds, Hm, FH, nullptr, S, E, tid);
}
                        if (BOTH(pb + 6)) GRID_BAR();
        }
        if (IN(pb + 7)) {
            PHASE_IDS();
            for (int m0 = gw * 8; m0 < NTOK; m0 += NGW * 8) {
                const int b = m0 / SEQ; const float* mb = modl + (size_t)b * 6 * D;
                const int sv = sop[m0 * 2 + (lane & 15)]; const float wv = ew[m0 * 2 + (lane & 15)];
                f32x4 g2[4];
#pragma unroll
                for (int j = 0; j < 4; ++j) g2[j] = *(const f32x4*)(mb + 5 * D + 4 * lane + 256 * j);
#pragma unroll 1
                for (int hb = 0; hb < 2; ++hb) {
                    f32x4 v[4][4]; v2u ya[4][4], yc[4][4]; float w0[4], w1[4];
#pragma unroll
                    for (int i = 0; i < 4; ++i) { const int r = hb * 4 + i; const int sa = __shfl(sv, 2 * r), sc_ = __shfl(sv, 2 * r + 1); w0[i] = __shfl(wv, 2 * r); w1[i] = __shfl(wv, 2 * r + 1);
#pragma unroll
                        for (int j = 0; j < 4; ++j) { v[i][j] = ((const GAS f32x4*)(xs + (size_t)(m0 + r) * D) + lane)[64 * j];
                            ya[i][j] = ((const GAS v2u*)(Yd + (size_t)sa * D) + lane)[64 * j]; yc[i][j] = ((const GAS v2u*)(Yd + (size_t)sc_ * D) + lane)[64 * j]; } }
#pragma unroll
                    for (int i = 0; i < 4; ++i) {
#pragma unroll
                        for (int j = 0; j < 4; ++j) { const v2u a = ya[i][j], c = yc[i][j];
                            f32x4 y; y.x = w0[i] * bf_lo(a.x) + w1[i] * bf_lo(c.x); y.y = w0[i] * bf_hi(a.x) + w1[i] * bf_hi(c.x); y.z = w0[i] * bf_lo(a.y) + w1[i] * bf_lo(c.y); y.w = w0[i] * bf_hi(a.y) + w1[i] * bf_hi(c.y);
                            v[i][j] = v[i][j] + g2[j] * y; } }
                    asm volatile("" ::: "memory");
                    f32x4 g[4], s1[4], s0[4];
                    if (l + 1 < DEPTH) { const float* mn = mod + ((size_t)(l + 1) * BATCH + b) * 6 * D; load_mod(g, s1, s0, norm1_g + (l + 1) * D, mn, mn + D, lane); }
                    else load_mod(g, s1, s0, args.in[22], nullptr, nullptr, lane);
#pragma unroll
                    for (int i = 0; i < 4; ++i) { const int r = hb * 4 + i; GAS f32x4* xr = (GAS f32x4*)(xs + (size_t)(m0 + r) * D) + lane;
                        if (l + 1 < DEPTH) {
#pragma unroll
                            for (int j = 0; j < 4; ++j) xr[64 * j] = v[i][j];
                            norm_apply(v[i], g, s1, s0, 1e-6f); store_row_bf16(XN + (size_t)(m0 + r) * D, v[i], lane);
                        } else { norm_apply(v[i], g, s1, s0, 1e-6f);
#pragma unroll
                            for (int j = 0; j < 4; ++j) xr[64 * j] = v[i][j]; } }
                }
            }
            if (BOTH(pb + 7)) GRID_BAR();
        }
    }
#undef IN
#undef BOTH
}

extern "C" void kernel_launch(void* const* d_in, const int* in_sizes, int n_in, void* d_out, int out_size, void* d_ws, size_t ws_size, hipStream_t stream) {
    static int grid = 0;
    if (grid == 0) {
        if (n_in != 23 || out_size != NTOK * D || ws_size < WS_END) { fprintf(stderr, "kernel_launch: unexpected shapes (n_in %d out %d ws %zu)\n", n_in, out_size, ws_size); grid = -1; return; }
        int dev = 0, cus = 0, per_cu = 0;
        if (hipGetDevice(&dev) != hipSuccess || hipDeviceGetAttribute(&cus, hipDeviceAttributeMultiprocessorCount, dev) != hipSuccess) { grid = -1; return; }
        if (hipFuncSetAttribute((const void*)fwd, hipFuncAttributeMaxDynamicSharedMemorySize, LDS_BYTES) != hipSuccess) { fprintf(stderr, "kernel_launch: hipFuncSetAttribute failed\n"); grid = -1; return; }
        if (hipOccupancyMaxActiveBlocksPerMultiprocessor(&per_cu, (const void*)fwd, NTHR, LDS_BYTES) != hipSuccess || per_cu < 1) fprintf(stderr, "kernel_launch: occupancy query reports %d\n", per_cu);
        (void)hipGetLastError();
        grid = cus;
        if (grid != 256) { fprintf(stderr, "kernel_launch: built for 256 CUs, found %d\n", cus); grid = -1; return; }
    }
    if (grid < 0) return;
    (void)in_sizes;
    if (hipMemsetAsync((char*)d_ws + WS_CTL, 0, CTL_ZERO_BYTES, stream) != hipSuccess) return;
    Args a{};
    for (int i = 0; i < 23; ++i) a.in[i] = (const float*)d_in[i];
    a.out = (float*)d_out; a.ws = (unsigned char*)d_ws;
#if MK_ONE_LAUNCH
    a.ph_lo = 0; a.ph_hi = NPHASE;
    hipLaunchKernelGGL(fwd, dim3(grid), dim3(NTHR), LDS_BYTES, stream, a);
#else
    for (int p = 0; p < NPHASE; ++p) { a.ph_lo = p; a.ph_hi = p + 1; hipLaunchKernelGGL(fwd, dim3(grid), dim3(NTHR), LDS_BYTES, stream, a); }
#endif
}
```

```cpp
#include <hip/hip_runtime.h>
#include <cstdio>
#include <cstdint>
#include <cmath>

#ifndef REPMASK
#define REPMASK 0
#endif
#define NREP(bit, cond) ((((REPMASK) >> (bit)) & 1) && (cond) ? 2 : 1)
#ifndef MK_ONE_LAUNCH
#define MK_ONE_LAUNCH 1
#endif

namespace pg8 {
#define PG8_LAS __attribute__((address_space(3)))
typedef unsigned short bf16_t;
typedef short bf16x8 __attribute__((ext_vector_type(8)));
typedef float f32x4 __attribute__((ext_vector_type(4)));
typedef unsigned u32x4 __attribute__((ext_vector_type(4)));
constexpr int BM = 256, BK = 64, HALF = 128, HTB = HALF * BK * 2, NXCD = 8, WGM = 8;

__host__ __device__ __forceinline__ int lds_byte(int r, int c) { const int st = (r >> 4) * 2 + (c >> 5), rr = r & 15, cc = c & 31, ob = rr * 64 + cc * 2; return st * 1024 + (ob ^ (((ob >> 9) & 1) << 5)); }
__host__ __device__ __forceinline__ void stage_rc(int b, int& R, int& C) { const int st = b / 1024, sb = b % 1024, swz = sb ^ (((sb >> 9) & 1) << 5); R = (st >> 1) * 16 + swz / 64; C = (st & 1) * 32 + (swz % 64) / 2; }
__host__ __device__ __forceinline__ int perm32(int rho) { const int n = rho >> 4, i = rho & 15; return 8 * (i >> 2) + 4 * n + (i & 3); }

struct Unit { int pm, pn; const bf16_t* Bt; };

struct StaticOrder {
    int nM, nN, nwg, G, c; const bf16_t* Bt;
    __device__ void init(int M, int N, int G_, int c_, const bf16_t* Bt_) { nM = M / BM; nN = N / BM; nwg = nM * nN; G = G_; c = c_; Bt = Bt_; }
    __device__ bool next(int i, Unit& u) const {
        const long L = (long)i * G + c; if (L >= nwg) return false;
        int wgid = (int)L; { const int q = nwg / NXCD, r = nwg % NXCD, xcd = wgid % NXCD, off = wgid / NXCD; wgid = (xcd < r ? xcd * (q + 1) : r * (q + 1) + (xcd - r) * q) + off; }
        const int nig = WGM * nN, gid = wgid / nig, fm = gid * WGM, gsz = (nM - fm) < WGM ? (nM - fm) : WGM;
        u.pm = fm + ((wgid % nig) % gsz); u.pn = (wgid % nig) / gsz; u.Bt = Bt; return true;
    }
};
struct GroupedOrder {
    const PG8_LAS int* tl; int G, c; const bf16_t* Bt; size_t estride;
    __device__ bool next(int i, Unit& u) const {
        const int L = i * G + c; const int nt = tl[0]; if (L >= nt * 4) return false;
        u.pm = L >> 2; u.pn = L & 3; u.Bt = Bt + (size_t)tl[1 + (L >> 2)] * estride; return true;
    }
};

__device__ __forceinline__ unsigned cvt_pk_bf16(float lo, float hi) { unsigned r; asm volatile("v_cvt_pk_bf16_f32 %0, %1, %2" : "=v"(r) : "v"(lo), "v"(hi)); return r; }

struct EpiBf16 {
    static constexpr bool PERM = true;
    bf16_t* O; int ldc; int split_cols; size_t split_stride; float scale0;
    __device__ __forceinline__ void operator()(const f32x4 (&acc)[2][2][4][2], const Unit& u, int wr, int wc, int fr, int fq) const {
        const int row0 = u.pm * BM + wr * 64 + fr; int colt = u.pn * BM; bf16_t* base = O;
        float sc = 1.f; if (split_cols) { const int t = colt / split_cols; base += (size_t)t * split_stride; colt -= t * split_cols; if (t == 0) sc = scale0; }
        const int col0 = colt + wc * 32 + 8 * fq;
#pragma unroll
        for (int ai = 0; ai < 2; ++ai)
#pragma unroll
            for (int m = 0; m < 4; ++m) { bf16_t* rowp = base + (size_t)(row0 + ai * HALF + m * 16) * ldc + col0;
#pragma unroll
                for (int bj = 0; bj < 2; ++bj) { const f32x4 v0 = acc[ai][bj][m][0] * sc, v1 = acc[ai][bj][m][1] * sc;
                    u32x4 w; w.x = cvt_pk_bf16(v0[0], v0[1]); w.y = cvt_pk_bf16(v0[2], v0[3]); w.z = cvt_pk_bf16(v1[0], v1[1]); w.w = cvt_pk_bf16(v1[2], v1[3]);
                    *(u32x4*)(rowp + bj * HALF) = w; } }
    }
};
struct EpiResid {
    static constexpr bool PERM = true;
    bf16_t* XO; const float* Xf; const bf16_t* Xb; int ldc; const float* gate; int gstride; int rows_per_batch;
    __device__ __forceinline__ void operator()(const f32x4 (&acc)[2][2][4][2], const Unit& u, int wr, int wc, int fr, int fq) const {
        const int row0 = u.pm * BM + wr * 64 + fr, col0 = u.pn * BM + wc * 32 + 8 * fq;
        const float* gp = gate + (size_t)((u.pm * BM) / rows_per_batch) * gstride + col0;
        f32x4 gv[2][2];
#pragma unroll
        for (int bj = 0; bj < 2; ++bj)
#pragma unroll
            for (int n = 0; n < 2; ++n) gv[bj][n] = *(const f32x4*)(gp + bj * HALF + n * 4);
#pragma unroll
        for (int ai = 0; ai < 2; ++ai)
#pragma unroll
            for (int m = 0; m < 4; ++m) { const size_t ro = (size_t)(row0 + ai * HALF + m * 16) * ldc + col0;
#pragma unroll
                for (int bj = 0; bj < 2; ++bj) { f32x4 x0, x1;
                    if (Xf) { x0 = *(const f32x4*)(Xf + ro + bj * HALF); x1 = *(const f32x4*)(Xf + ro + bj * HALF + 4); }
                    else { const u32x4 xb = *(const u32x4*)(Xb + ro + bj * HALF);
                        x0 = (f32x4){__builtin_bit_cast(float, xb.x << 16), __builtin_bit_cast(float, xb.x & 0xffff0000u), __builtin_bit_cast(float, xb.y << 16), __builtin_bit_cast(float, xb.y & 0xffff0000u)};
                        x1 = (f32x4){__builtin_bit_cast(float, xb.z << 16), __builtin_bit_cast(float, xb.z & 0xffff0000u), __builtin_bit_cast(float, xb.w << 16), __builtin_bit_cast(float, xb.w & 0xffff0000u)}; }
                    const f32x4 v0 = x0 + gv[bj][0] * acc[ai][bj][m][0], v1 = x1 + gv[bj][1] * acc[ai][bj][m][1];
                    u32x4 w; w.x = cvt_pk_bf16(v0[0], v0[1]); w.y = cvt_pk_bf16(v0[2], v0[3]); w.z = cvt_pk_bf16(v1[0], v1[1]); w.w = cvt_pk_bf16(v1[2], v1[3]);
                    *(u32x4*)(XO + ro + bj * HALF) = w; } }
    }
};
struct EpiSwiGLU {
    static constexpr bool PERM = true;
    bf16_t* H; int ldh;
    __device__ __forceinline__ void operator()(const f32x4 (&acc)[2][2][4][2], const Unit& u, int wr, int wc, int fr, int fq) const {
        const int row0 = u.pm * BM + wr * 64 + fr, col0 = u.pn * HALF + wc * 32 + 8 * fq;
#pragma unroll
        for (int ai = 0; ai < 2; ++ai)
#pragma unroll
            for (int m = 0; m < 4; ++m) { bf16_t* rowp = H + (size_t)(row0 + ai * HALF + m * 16) * ldh + col0;
                float hv[8];
#pragma unroll
                for (int n = 0; n < 2; ++n)
#pragma unroll
                    for (int j = 0; j < 4; ++j) { const float g = acc[ai][0][m][n][j], uu = acc[ai][1][m][n][j]; hv[n * 4 + j] = g * __builtin_amdgcn_rcpf(1.f + __builtin_amdgcn_exp2f(-1.4426950408889634f * g)) * uu; }
                u32x4 w; w.x = cvt_pk_bf16(hv[0], hv[1]); w.y = cvt_pk_bf16(hv[2], hv[3]); w.z = cvt_pk_bf16(hv[4], hv[5]); w.w = cvt_pk_bf16(hv[6], hv[7]);
                *(u32x4*)rowp = w; }
    }
};

template <class Epi, class Sched, bool GATHER>
__device__ __forceinline__ void gemm_phase(PG8_LAS unsigned char* lds, const bf16_t* Ab_, const int K, const PG8_LAS int* gidx, const Sched& S, const Epi& E, const int tid) {
    const int wid = __builtin_amdgcn_readfirstlane(tid >> 6), lane = tid & 63, wr = wid >> 2, wc = wid & 3, fr = lane & 15, fq = lane >> 4;
    const int nt = K / BK;
    const char* Ab = (const char*)Ab_;
    int RA[2]; unsigned CA2[2], voffB[2];
#pragma unroll
    for (int i = 0; i < 2; ++i) { int R, C; stage_rc(tid * 16 + i * 8192, R, C); const int Rb = Epi::PERM ? ((R & ~31) + perm32(R & 31)) : R;
        RA[i] = R; CA2[i] = (unsigned)C * 2u; voffB[i] = (unsigned)(Rb * K + C) * 2u; }
    const unsigned rowbytes = (unsigned)K * 2u;
    const unsigned kstep = (unsigned)(BK * 2);
    const size_t hstep = (size_t)HALF * K * 2;
    const size_t tstep = 2 * hstep;
    const unsigned ldsw = (unsigned)wid * 1024u;
    const int aoff = lds_byte(wr * 64 + fr, fq * 8), boff = lds_byte(wc * 32 + fr, fq * 8);
#define PG8_SA(b, h) (((b) * 2 + (h)) * HTB)
#define PG8_SB(b, h) ((4 + (b) * 2 + (h)) * HTB)
#define PG8_STAGEB(bufoff, gbase) do { _Pragma("unroll") for (int _i = 0; _i < 2; ++_i) \
        __builtin_amdgcn_global_load_lds((const unsigned*)((const char*)(gbase) + voffB[_i]), (PG8_LAS unsigned*)(lds + (bufoff) + ldsw + _i * 8192), 16, 0, 0); } while (0)
#define PG8_STAGEA(bufoff, o0, o1) do { \
        __builtin_amdgcn_global_load_lds((const unsigned*)(Ab + (o0)), (PG8_LAS unsigned*)(lds + (bufoff) + ldsw), 16, 0, 0); \
        __builtin_amdgcn_global_load_lds((const unsigned*)(Ab + (o1)), (PG8_LAS unsigned*)(lds + (bufoff) + ldsw + 8192), 16, 0, 0); } while (0)
#define PG8_LDA(dst, b, h) do { _Pragma("unroll") for (int m = 0; m < 4; ++m) _Pragma("unroll") for (int k = 0; k < 2; ++k) dst[m][k] = *(const PG8_LAS bf16x8*)(lds + PG8_SA(b, h) + aoff + m * 2048 + k * 1024); } while (0)
#define PG8_LDB(dst, b, h) do { _Pragma("unroll") for (int n = 0; n < 2; ++n) _Pragma("unroll") for (int k = 0; k < 2; ++k) dst[n][k] = *(const PG8_LAS bf16x8*)(lds + PG8_SB(b, h) + boff + n * 2048 + k * 1024); } while (0)
#define PG8_MMA(ai, bj, At, Bt) do { __builtin_amdgcn_s_setprio(1); _Pragma("unroll") for (int m = 0; m < 4; ++m) _Pragma("unroll") for (int n = 0; n < 2; ++n) _Pragma("unroll") for (int k = 0; k < 2; ++k) \
        acc[ai][bj][m][n] = __builtin_amdgcn_mfma_f32_16x16x32_bf16(Bt[n][k], At[m][k], acc[ai][bj][m][n], 0, 0, 0); __builtin_amdgcn_s_setprio(0); } while (0)
#define PG8_WAIT_V(n) asm volatile("s_waitcnt vmcnt(" #n ")" ::: "memory")
#define PG8_WAIT_L(n) asm volatile("s_waitcnt lgkmcnt(" #n ")" ::: "memory")
#define PG8_BAR __builtin_amdgcn_s_barrier()
#define PG8_SCHED __builtin_amdgcn_sched_barrier(0)
#define PG8_MKOFF(dst, u, ui_) do { _Pragma("unroll") for (int h = 0; h < 2; ++h) _Pragma("unroll") for (int i = 0; i < 2; ++i) { \
        int row_ = (u).pm * BM + h * HALF + RA[i]; if (GATHER) row_ = gidx[(ui_) * BM + h * HALF + RA[i]]; dst[h][i] = (unsigned)row_ * rowbytes + CA2[i]; } } while (0)
    Unit cur, nxt; int ui = 0;
    if (!S.next(0, cur)) return;
    f32x4 acc[2][2][4][2];
#pragma unroll
    for (int a = 0; a < 2; ++a)
#pragma unroll
        for (int b = 0; b < 2; ++b)
#pragma unroll
            for (int m = 0; m < 4; ++m)
#pragma unroll
                for (int n = 0; n < 2; ++n) acc[a][b][m][n] = (f32x4){0.f, 0.f, 0.f, 0.f};
    bf16x8 At[4][2], B0[2][2], B1[2][2];
    unsigned curo[2][2], nxto[2][2];
    PG8_MKOFF(curo, cur, 0);
    const char* cB = (const char*)cur.Bt + (size_t)cur.pn * tstep;
    PG8_STAGEB(PG8_SB(0, 0), cB); PG8_STAGEB(PG8_SB(0, 1), cB + hstep); PG8_STAGEA(PG8_SA(0, 0), curo[0][0], curo[0][1]); PG8_STAGEA(PG8_SA(0, 1), curo[1][0], curo[1][1]);
    if (wr == 1) PG8_BAR;
    PG8_WAIT_V(2); PG8_BAR;
    PG8_STAGEB(PG8_SB(1, 0), cB + kstep); PG8_STAGEA(PG8_SA(1, 0), curo[0][0] + kstep, curo[0][1] + kstep); PG8_STAGEB(PG8_SB(1, 1), cB + hstep + kstep);
    PG8_WAIT_V(6); PG8_BAR;
    for (;;) {
        const bool has_next = S.next(ui + 1, nxt);
        if (has_next) { PG8_MKOFF(nxto, nxt, ui + 1); } else {
#pragma unroll
            for (int h = 0; h < 2; ++h)
#pragma unroll
                for (int i = 0; i < 2; ++i) nxto[h][i] = curo[h][i]; }
        const char* nB = has_next ? (const char*)nxt.Bt + (size_t)nxt.pn * tstep : cB;
        for (int t = 0; t < nt; t += 2) {
            const bool last = (t == nt - 2);
            const unsigned kb1 = (unsigned)(t + 1) * kstep, kb2 = last ? 0u : (unsigned)(t + 2) * kstep, kb3 = kb2 + kstep;
            const unsigned s00 = last ? nxto[0][0] : curo[0][0], s01 = last ? nxto[0][1] : curo[0][1], s10 = last ? nxto[1][0] : curo[1][0], s11 = last ? nxto[1][1] : curo[1][1];
            const char* b2 = last ? nB : cB + (size_t)(t + 2) * kstep; const char* b3 = b2 + kstep;
            PG8_LDB(B0, 0, 0); PG8_LDB(B1, 0, 1); PG8_SCHED; PG8_LDA(At, 0, 0); PG8_STAGEA(PG8_SA(1, 1), curo[1][0] + kb1, curo[1][1] + kb1);
            PG8_WAIT_V(8); PG8_WAIT_L(0); PG8_BAR; PG8_MMA(0, 0, At, B0); PG8_MMA(0, 1, At, B1); PG8_BAR; PG8_SCHED;
            PG8_LDA(At, 0, 1); PG8_STAGEB(PG8_SB(0, 0), b2); PG8_STAGEB(PG8_SB(0, 1), b2 + hstep); PG8_STAGEA(PG8_SA(0, 0), s00 + kb2, s01 + kb2);
            PG8_WAIT_V(8); PG8_WAIT_L(0); PG8_BAR; PG8_MMA(1, 0, At, B0); PG8_MMA(1, 1, At, B1); PG8_BAR; PG8_SCHED;
            PG8_LDB(B0, 1, 0); PG8_LDB(B1, 1, 1); PG8_SCHED; PG8_LDA(At, 1, 0); PG8_STAGEA(PG8_SA(0, 1), s10 + kb2, s11 + kb2);
            PG8_WAIT_V(8); PG8_WAIT_L(0); PG8_BAR; PG8_MMA(0, 0, At, B0); PG8_MMA(0, 1, At, B1); PG8_BAR; PG8_SCHED;
            PG8_LDA(At, 1, 1); PG8_STAGEB(PG8_SB(1, 0), b3); PG8_STAGEB(PG8_SB(1, 1), b3 + hstep); PG8_STAGEA(PG8_SA(1, 0), s00 + kb3, s01 + kb3);
            PG8_WAIT_V(8); PG8_WAIT_L(0); PG8_BAR; PG8_MMA(1, 0, At, B0); PG8_MMA(1, 1, At, B1); PG8_BAR; PG8_SCHED;
        }
        if (wr == 0) PG8_BAR;
        E(acc, cur, wr, wc, fr, fq);
        if (!has_next) break;
#pragma unroll
        for (int a = 0; a < 2; ++a)
#pragma unroll
            for (int b = 0; b < 2; ++b)
#pragma unroll
                for (int m = 0; m < 4; ++m)
#pragma unroll
                    for (int n = 0; n < 2; ++n) acc[a][b][m][n] = (f32x4){0.f, 0.f, 0.f, 0.f};
        cur = nxt; cB = nB; ++ui;
#pragma unroll
        for (int h = 0; h < 2; ++h)
#pragma unroll
            for (int i = 0; i < 2; ++i) curo[h][i] = nxto[h][i];
        if (wr == 1) PG8_BAR;
    }
    PG8_WAIT_V(0);
    PG8_BAR;
#undef PG8_SA
#undef PG8_SB
#undef PG8_STAGEA
#undef PG8_STAGEB
#undef PG8_LDA
#undef PG8_LDB
#undef PG8_MMA
#undef PG8_WAIT_V
#undef PG8_WAIT_L
#undef PG8_BAR
#undef PG8_SCHED
#undef PG8_MKOFF
}
}

constexpr int NWAVES = 8, NTHR = NWAVES * 64;
constexpr int D = 1024, BATCH = 8, SEQ = 2048, NTOK = BATCH * SEQ, DEPTH = 2;
constexpr int NG = 4, EPG = 8, NE = 32, FH = 512, NPAIR = NTOK * 2;
constexpr int MAX_SLOTS = NPAIR + NE * 256;
constexpr int MAX_TILES = MAX_SLOTS / 256;
constexpr int NPHASE = 2 + 8 * DEPTH;
constexpr float C2 = 0.125f * 1.4426950408889634f;
constexpr float LOG2E = 1.4426950408889634f, LN2 = 0.6931471805599453f;

constexpr size_t MiB = 1u << 20;
constexpr size_t WS_CTL = 0, CTL_ZERO_BYTES = 1 * MiB;
constexpr size_t WS_MOD = 1 * MiB;
constexpr size_t WS_EID = 2 * MiB, WS_EW = 3 * MiB, WS_HIST = 4 * MiB, WS_SOP = 5 * MiB, WS_STOK = 6 * MiB, WS_TILES = 7 * MiB;
constexpr size_t LSTRIDE = 512 * 1024;
constexpr size_t WS_RT = 1 * MiB + 512 * 1024;
constexpr size_t WS_W = 8 * MiB, W_LAYER = 104 * MiB, W_IN = 0, W_OUT = 6 * MiB, W_GU = 8 * MiB, W_DN = 72 * MiB;
constexpr size_t WS_XN = 216 * MiB;
constexpr size_t WS_Q = 248 * MiB, WS_K = 280 * MiB, WS_V = 312 * MiB, WS_O = 344 * MiB;
constexpr size_t WS_HM = 248 * MiB;
constexpr size_t WS_YD = 288 * MiB;
constexpr size_t WS_XS = 376 * MiB;
constexpr size_t WS_END = 408 * MiB;
constexpr int CW_BAR = 4096;
constexpr int RING_BYTES = 131072, AUX_OFF = 131072, MISC_OFF = 147456, LDS_BYTES = 163840;

#define GAS __attribute__((address_space(1)))
#define LAS __attribute__((address_space(3)))
typedef unsigned short bf16;
typedef unsigned v4u __attribute__((ext_vector_type(4)));
typedef unsigned v2u __attribute__((ext_vector_type(2)));
typedef float f32x4 __attribute__((ext_vector_type(4)));
typedef GAS unsigned gu32;
#define RLX_AGENT __ATOMIC_RELAXED, __HIP_MEMORY_SCOPE_AGENT
#define LDS_WAIT() asm volatile("s_waitcnt lgkmcnt(0)" ::: "memory")
__device__ __forceinline__ unsigned f2bf(float f) { unsigned u = __builtin_bit_cast(unsigned, f); return (u + 0x7fffu + ((u >> 16) & 1u)) >> 16; }
__device__ __forceinline__ unsigned pk2(float lo, float hi) { return f2bf(lo) | (f2bf(hi) << 16); }
__device__ __forceinline__ float bf_lo(unsigned w) { return __builtin_bit_cast(float, w << 16); }
__device__ __forceinline__ float bf_hi(unsigned w) { return __builtin_bit_cast(float, w & 0xffff0000u); }
__device__ __forceinline__ int vzero() { int z = 0; asm volatile("" : "+v"(z)); return z; }

#define XB_TMO      128
#define XB_XCNT(j)  (256  + 64 * (j))
#define XB_XSUB(j)  (1280 + 64 * (j))
#define XB_XGEN(j)  (2304 + 64 * (j))
#define XB_TOP      3328
#define XB_TOPGEN   3392
#define XCD_BAR_WORDS 3456
#define XB_SPIN_CAP (1u << 18)
__device__ __forceinline__ unsigned xb_ld(unsigned* p)              { return __hip_atomic_load(p, __ATOMIC_RELAXED, __HIP_MEMORY_SCOPE_AGENT); }
__device__ __forceinline__ unsigned xb_add(unsigned* p, unsigned v) { return __hip_atomic_fetch_add(p, v, __ATOMIC_RELAXED, __HIP_MEMORY_SCOPE_AGENT); }
__device__ __forceinline__ unsigned xb_xcc_id() { return (unsigned)__builtin_amdgcn_s_getreg((3 << 11) | 20) & 0xFu; }
#define XB_SPIN(cond, bar) do { unsigned _sp = 0; while (cond) { __builtin_amdgcn_s_sleep(1); \
    if ((++_sp & 255u) == 0u) { if (xb_ld(&(bar)[XB_TMO])) break; if (_sp > XB_SPIN_CAP) { atomicAdd(&(bar)[XB_TMO], 1u); break; } } } } while (0)
struct XcdBarrier { unsigned* bar; unsigned x; volatile LAS unsigned* st; };
__device__ __forceinline__ XcdBarrier xcd_barrier_post(unsigned* bar, volatile LAS unsigned* st) {
    XcdBarrier b; b.bar = bar; b.x = xb_xcc_id(); b.st = st;
    if (threadIdx.x == 0) (void)xb_add(&bar[XB_XCNT(b.x)], 1u);
    return b;
}
__device__ __forceinline__ void xcd_barrier_complete(unsigned* bar, unsigned x, unsigned& nloc, unsigned& nx) {
    const unsigned G = gridDim.x * gridDim.y * gridDim.z;
    unsigned sum, cnt, mine, sp = 0u;
    for (;;) {
        sum = 0u; cnt = 0u; mine = 0u;
#pragma unroll
        for (unsigned j = 0; j < 16; ++j) { const unsigned c = xb_ld(&bar[XB_XCNT(j)]); sum += c; cnt += (c > 0u) ? 1u : 0u; mine = (j == x) ? c : mine; }
        if (sum == G) break;
        __builtin_amdgcn_s_sleep(1);
        if ((++sp & 255u) == 0u) { if (xb_ld(&bar[XB_TMO])) break; if (sp > XB_SPIN_CAP) { atomicAdd(&bar[XB_TMO], 1u); break; } }
    }
    nloc = mine > 0u ? mine : 1u; nx = cnt > 0u ? cnt : 1u;
}
__device__ __forceinline__ void xcd_barrier(const XcdBarrier& b) {
    asm volatile("s_waitcnt vmcnt(0)" ::: "memory");
    __syncthreads();
    if (threadIdx.x == 0) {
        unsigned* bar = b.bar;
        __builtin_amdgcn_s_waitcnt(0);
        unsigned nloc = b.st[0], nx = b.st[1];
        if (nloc == 0u) { xcd_barrier_complete(bar, b.x, nloc, nx); b.st[0] = nloc; b.st[1] = nx; }
        const unsigned old = xb_add(&bar[XB_XSUB(b.x)], 1u);
        const unsigned gen = old / nloc;
        if (old + 1u == (gen + 1u) * nloc) {
            __builtin_amdgcn_fence(__ATOMIC_RELEASE, "agent");
            asm volatile("s_waitcnt vmcnt(0)" ::: "memory");
            const unsigned og = xb_add(&bar[XB_TOP], 1u);
            const unsigned tg = og / nx;
            if (og + 1u == (tg + 1u) * nx) xb_add(&bar[XB_TOPGEN], 1u);
            else XB_SPIN(xb_ld(&bar[XB_TOPGEN]) == tg, bar);
            __builtin_amdgcn_fence(__ATOMIC_ACQUIRE, "agent");
            xb_add(&bar[XB_XGEN(b.x)], 1u);
            asm volatile("s_waitcnt vmcnt(0)" ::: "memory");
        } else {
            XB_SPIN(xb_ld(&bar[XB_XGEN(b.x)]) == gen, bar);
            __builtin_amdgcn_fence(__ATOMIC_ACQUIRE, "agent");
            asm volatile("s_waitcnt vmcnt(0)" ::: "memory");
        }
    }
    __syncthreads();
}

template <int X> __device__ __forceinline__ float swz_xor(float v) { return __builtin_bit_cast(float, __builtin_amdgcn_ds_swizzle(__builtin_bit_cast(int, v), 0x1f | (X << 10))); }
__device__ __forceinline__ float wave_sum(float v) {
    v += swz_xor<1>(v); v += swz_xor<2>(v); v += swz_xor<4>(v); v += swz_xor<8>(v); v += swz_xor<16>(v);
    const unsigned a = __float_as_uint(v);
    auto rr = __builtin_amdgcn_permlane32_swap(a, a, false, false);
    const unsigned r0 = rr[0], r1 = rr[1];
    return __uint_as_float(r0) + __uint_as_float(r1);
}
struct ConvItem { const float* W; bf16* WT; int K, N, drow, k0, n0; };
__device__ __forceinline__ void conv_issue(f32x4 (&t)[8], const ConvItem& c, int lane) {
    const GAS float* src = (const GAS float*)c.W + (size_t)(c.k0 + (lane >> 3)) * c.N + c.n0 + 4 * (lane & 7);
#pragma unroll
    for (int i = 0; i < 8; ++i) t[i] = *(const GAS f32x4*)(src + (size_t)(8 * i) * c.N);
}
__device__ __forceinline__ void conv_finish(const f32x4 (&t)[8], const ConvItem& c, LAS float* scr, int lane) {
    { LAS float* d = scr + (lane >> 3) * 33 + 4 * (lane & 7);
#pragma unroll
      for (int i = 0; i < 8; ++i) { d[(8 * i) * 33 + 0] = t[i].x; d[(8 * i) * 33 + 1] = t[i].y; d[(8 * i) * 33 + 2] = t[i].z; d[(8 * i) * 33 + 3] = t[i].w; } }
    LDS_WAIT(); asm volatile("" ::: "memory");
    const int cc = lane & 7;
#pragma unroll
    for (int j = 0; j < 4; ++j) { const int n = (lane >> 3) + 8 * j; const LAS float* sp = scr + (8 * cc) * 33 + n;
        v4u o; o.x = pk2(sp[0 * 33], sp[1 * 33]); o.y = pk2(sp[2 * 33], sp[3 * 33]); o.z = pk2(sp[4 * 33], sp[5 * 33]); o.w = pk2(sp[6 * 33], sp[7 * 33]);
        *(GAS v4u*)(c.WT + (size_t)(c.drow + n) * c.K + c.k0 + 8 * cc) = o; }
    LDS_WAIT(); asm volatile("" ::: "memory");
}
__device__ __forceinline__ void load_mod(f32x4 (&g)[4], f32x4 (&s1)[4], f32x4 (&s0)[4], const float* gp, const float* sh, const float* sc, int lane) {
#pragma unroll
    for (int j = 0; j < 4; ++j) { const int c0 = 4 * lane + 256 * j; g[j] = *(const f32x4*)(gp + c0);
        if (sc) { s1[j] = *(const f32x4*)(sc + c0) + 1.f; s0[j] = *(const f32x4*)(sh + c0); } else { s1[j] = (f32x4){1.f, 1.f, 1.f, 1.f}; s0[j] = (f32x4){0.f, 0.f, 0.f, 0.f}; } }
}
__device__ __forceinline__ void norm_apply(f32x4 (&v)[4], const f32x4 (&g)[4], const f32x4 (&s1)[4], const f32x4 (&s0)[4], float eps) {
    float ss = 0.f;
#pragma unroll
    for (int j = 0; j < 4; ++j) ss += (v[j].x * v[j].x + v[j].y * v[j].y) + (v[j].z * v[j].z + v[j].w * v[j].w);
    const float r = 1.0f / sqrtf(wave_sum(ss) * (1.f / D) + eps);
#pragma unroll
    for (int j = 0; j < 4; ++j) v[j] = (v[j] * r * g[j]) * s1[j] + s0[j];
}
__device__ __forceinline__ void store_row_bf16(bf16* orow, const f32x4 (&v)[4], int lane) {
    GAS unsigned long long* o8 = (GAS unsigned long long*)orow + lane;
#pragma unroll
    for (int j = 0; j < 4; ++j) o8[64 * j] = (unsigned long long)pk2(v[j].x, v[j].y) | ((unsigned long long)pk2(v[j].z, v[j].w) << 32);
}
__device__ __forceinline__ float dot8(const v4u kv, const LAS float* q) {
    return bf_lo(kv.x) * q[0] + bf_hi(kv.x) * q[1] + bf_lo(kv.y) * q[2] + bf_hi(kv.y) * q[3] + bf_lo(kv.z) * q[4] + bf_hi(kv.z) * q[5] + bf_lo(kv.w) * q[6] + bf_hi(kv.w) * q[7];
}


namespace att {
typedef short bf16x8 __attribute__((ext_vector_type(8)));
typedef short s16x4 __attribute__((ext_vector_type(4)));
typedef short v4i16_t __attribute__((ext_vector_type(4)));
typedef float f32x16 __attribute__((ext_vector_type(16)));
typedef unsigned u32x4 __attribute__((ext_vector_type(4)));
typedef float f32x2_t __attribute__((ext_vector_type(2))); typedef __bf16 bf16x2_t __attribute__((ext_vector_type(2)));
typedef LAS const unsigned char* lds_cptr;
__device__ __forceinline__ int crow(int r, int hi) { return (r & 3) + 8 * (r >> 2) + 4 * hi; }
__device__ __forceinline__ int kperm(int i) { return 16 * ((i >> 2) & 1) + (i & 3) + 4 * (i >> 3); }
__device__ __forceinline__ void glds16(const void* gsrc, unsigned lds_dst) { unsigned keep;
    asm volatile("s_mov_b32 %0, m0\n\ts_mov_b32 m0, %2\n\ts_nop 0\n\tglobal_load_lds_dwordx4 %1, off\n\ts_mov_b32 m0, %0" : "=&s"(keep) : "v"(gsrc), "s"(lds_dst) : "memory"); }
__device__ __forceinline__ unsigned cvtpk_s(float lo, float hi) { f32x2_t v = {lo, hi}; bf16x2_t b = __builtin_convertvector(v, bf16x2_t); return __builtin_bit_cast(unsigned, b); }
__device__ __forceinline__ s16x4 vtr(lds_cptr p) { return __builtin_bit_cast(s16x4, __builtin_amdgcn_ds_read_tr16_b64_v4i16((LAS v4i16_t*)p)); }
__device__ __forceinline__ float partner(float v, int hi) { auto rr = __builtin_amdgcn_permlane32_swap(__float_as_uint(v), __float_as_uint(v), false, false); return __uint_as_float(hi ? rr[0] : rr[1]); }
#define ATT_WAIT_BAR(N) asm volatile("s_waitcnt vmcnt(" #N ") lgkmcnt(0)\n\ts_barrier" ::: "memory")
#define ATT_PACK(P, B) (u32x4){cvtpk_s(P[B], P[B + 1]), cvtpk_s(P[B + 2], P[B + 3]), cvtpk_s(P[B + 4], P[B + 5]), cvtpk_s(P[B + 6], P[B + 7])}

__device__ __forceinline__ float max3f(float a, float b, float c) { float r; asm("v_max3_f32 %0, %1, %2, %3" : "=v"(r) : "v"(a), "v"(b), "v"(c)); return r; }
__device__ __forceinline__ float max2f(float a, float b) { float r; asm("v_max_f32_e32 %0, %1, %2" : "=v"(r) : "v"(a), "v"(b)); return r; }
template <int PV_>
__device__ __forceinline__ void diff_unit(int b, int h, int qb, const bf16* Q, const bf16* K, const bf16* V, bf16* O, LAS unsigned char* shm, float lam, const float* subg, int tid) {
    const int lane = tid & 63, r32 = lane & 31, hi = lane >> 5; const int wid = __builtin_amdgcn_readfirstlane(tid >> 6);
    const int m = wid >> 2, rg = wid & 3;
    const long rowbase = (long)b * SEQ; const int q0 = qb * 128;
    int hh_ = h + 1; asm volatile("" : "+s"(hh_) : "s"(qb));
    const float slope2 = __builtin_amdgcn_exp2f(-(float)hh_) * LOG2E;
    const unsigned lds0 = (unsigned)(uintptr_t)shm;
    LAS float* wsf = (LAS float*)(shm + 131072 + wid * 256);
    const bf16* dsrc; long dstep; unsigned ddst;
    int dswz = 0;
    if (wid < 4) { const int ri = lane >> 3, cp = lane & 7; const int key = 32 * (wid & 1) + 16 * ((ri >> 2) & 1) + (ri & 3); const int c0 = cp ^ ((ri >> 1) & 3);
        dsrc = K + (rowbase + key) * D + h * 128 + (wid >> 1) * 64 + c0 * 8; dstep = 4 * D; dswz = ((c0 ^ 4) - c0) * 8; ddst = ((wid >> 1) * 8 + 4 * (wid & 1)) * 1024; }
    else { dsrc = V + (rowbase + (lane >> 2)) * D + h * 128 + (wid - 4) * 32 + (lane & 3) * 8; dstep = 16 * D; ddst = 16384 + (wid - 4) * 4096; }
#define DIFF_DMA(j, slot) do { if (!(PV_ & 1)) { const unsigned d_ = (unsigned)__builtin_amdgcn_readfirstlane(lds0 + (slot) * 32768 + ddst); const bf16* s_ = dsrc + (long)(j) * 64 * D; \
        glds16(s_, d_); glds16(s_ + dstep, d_ + 1024); glds16(s_ + 2 * dstep + dswz, d_ + 2048); glds16(s_ + 3 * dstep + dswz, d_ + 3072); } } while (0)
    const int nt = 2 * qb + 2, jw = 2 * qb + (rg >> 1);
    DIFF_DMA(0, 0); DIFF_DMA(1, 1); if (nt > 2) DIFF_DMA(2, 2);
    bf16x8 qr[4];
    { const bf16* Qw = Q + (rowbase + q0 + 32 * rg) * D + h * 128 + m * 64;
#pragma unroll
      for (int d0 = 0; d0 < 4; ++d0) qr[d0] = *reinterpret_cast<const bf16x8*>(&Qw[(long)r32 * D + d0 * 16 + hi * 8]); }
    float mhat = 0.f, l_reg = 0.f; f32x16 o[4];
#pragma unroll
    for (int e = 0; e < 4; ++e) o[e] = f32x16{};
    const float tqf = (float)(q0 + 32 * rg + r32);
    const lds_cptr kp0 = (lds_cptr)shm + m * 8192 + (r32 >> 3) * 1024 + (r32 & 7) * 128;
    int koff[4];
    { const int fz = ((r32 >> 1) & 3) | (((r32 >> 4) & 1) << 2);
#pragma unroll
      for (int d0 = 0; d0 < 4; ++d0) koff[d0] = ((2 * d0 + hi) ^ fz) * 16; }
    const lds_cptr vp0 = (lds_cptr)shm + 16384 + hi * 1024 + ((lane & 15) >> 2) * 64 + ((lane >> 4) & 1) * 32 + (lane & 3) * 8;
    u32x4 pw0, pw1, pw2, pw3; f32x16 p0, p1;
#define QK_LOAD(st) do { const lds_cptr kp = kp0 + (st) * 32768; \
        _Pragma("unroll") for (int d0 = 0; d0 < 4; ++d0) { kf[2 * d0] = *(const LAS bf16x8*)(kp + koff[d0]); kf[2 * d0 + 1] = *(const LAS bf16x8*)(kp + 4096 + koff[d0]); } } while (0)
#define QK_CINIT(t) do { const float base0 = (float)(64 * (t) + 16 * hi) - tqf; \
        if ((t) < jw) { const float t0 = __builtin_fmaf(slope2, base0, -mhat), t1 = __builtin_fmaf(slope2, 32.f, t0); \
            _Pragma("unroll") for (int r = 0; r < 16; ++r) { p0[r] = __builtin_fmaf(slope2, (float)r, t0); p1[r] = __builtin_fmaf(slope2, (float)r, t1); } } \
        else { _Pragma("unroll") for (int r = 0; r < 16; ++r) { const float d0 = base0 + (float)r; p0[r] = __builtin_fmaf(-slope2, __builtin_fabsf(d0), -mhat); p1[r] = __builtin_fmaf(-slope2, __builtin_fabsf(d0 + 32.f), -mhat); } } } while (0)
#define QK_MMA() do { _Pragma("unroll") for (int d0 = 0; d0 < 4; ++d0) { p0 = __builtin_amdgcn_mfma_f32_32x32x16_bf16(kf[2 * d0], qr[d0], p0, 0, 0, 0); p1 = __builtin_amdgcn_mfma_f32_32x32x16_bf16(kf[2 * d0 + 1], qr[d0], p1, 0, 0, 0); } } while (0)
#define DIFF_QK(t, st) do { bf16x8 kf[8]; QK_LOAD(st); __builtin_amdgcn_sched_barrier(0); QK_CINIT(t); asm volatile("s_waitcnt lgkmcnt(0)" ::: "memory"); __builtin_amdgcn_sched_barrier(0); QK_MMA(); } while (0)
    int slot = 0, slot1 = 1, slot3 = 3;
    asm volatile("s_waitcnt vmcnt(0)\n\ts_barrier" ::: "memory");
    if (m == 0) DIFF_QK(0, 0);
    asm volatile("s_waitcnt lgkmcnt(0)\n\ts_barrier" ::: "memory");
    if (m == 1) { DIFF_QK(0, 0); asm volatile("s_waitcnt lgkmcnt(0)\n\ts_barrier" ::: "memory"); }
    for (int j = 0; j < ((PV_ & 8) ? 0 : nt); ++j) {
        if (m == 1 && j + 3 < nt) DIFF_DMA(j + 3, slot3);
        if (j <= jw && !(PV_ & 2)) {
            asm volatile("s_nop 15\n\ts_nop 7" : "+v"(p0), "+v"(p1));
            float rm;
            { float a = max3f(p0[0], p0[1], p1[0]), c = max3f(p0[2], p0[3], p1[1]); a = max3f(a, p1[2], p1[3]);
#pragma unroll
              for (int r = 4; r < 16; r += 4) { a = max3f(a, p0[r], p0[r + 1]); c = max3f(c, p0[r + 2], p0[r + 3]); a = max3f(a, p1[r], p1[r + 1]); c = max3f(c, p1[r + 2], p1[r + 3]); }
              rm = max2f(a, c); auto rr = __builtin_amdgcn_permlane32_swap(__float_as_uint(rm), __float_as_uint(rm), false, false); rm = max2f(__uint_as_float(rr[0]), __uint_as_float(rr[1])); }
            if (j == 0) { mhat = rm;
#pragma unroll
                for (int r = 0; r < 16; ++r) { p0[r] -= rm; p1[r] -= rm; } }
            else if (__any(rm > 8.f)) {
                const float dl = __builtin_fmaxf(rm, 0.f); mhat += dl;
#pragma unroll
                for (int r = 0; r < 16; ++r) { p0[r] -= dl; p1[r] -= dl; }
                const float f = __builtin_amdgcn_exp2f(-dl); l_reg *= f; if (hi == 0) wsf[r32] = f;
                asm volatile("s_waitcnt lgkmcnt(0)" ::: "memory");
#pragma unroll
                for (int e = 0; e < 4; ++e)
#pragma unroll
                    for (int r = 0; r < 16; ++r) o[e][r] *= wsf[crow(r, hi)];
            }
            float sacc = 0.f;
#pragma unroll
            for (int r = 0; r < 16; ++r) { p0[r] = __builtin_amdgcn_exp2f(p0[r]); p1[r] = __builtin_amdgcn_exp2f(p1[r]); sacc += p0[r] + p1[r]; }
            l_reg += sacc;
            pw0 = ATT_PACK(p0, 0); pw1 = ATT_PACK(p0, 8); pw2 = ATT_PACK(p1, 0); pw3 = ATT_PACK(p1, 8);
        }
        if (m == 0 && j + 1 < nt) { if (j + 2 < nt) asm volatile("s_waitcnt vmcnt(4)" ::: "memory"); else asm volatile("s_waitcnt vmcnt(0)" ::: "memory"); }
        asm volatile("s_waitcnt lgkmcnt(0)\n\ts_barrier" ::: "memory");
        if (m == 0 && j + 3 < nt) DIFF_DMA(j + 3, slot3);
        if (j <= jw && !(PV_ & 4)) {
            const lds_cptr vp = vp0 + slot * 32768;
            const bool doqk = (j + 1 < nt && j + 1 <= jw && !(PV_ & 16));
            bf16x8 kf[8]; s16x4 val[4], vah[4], vbl[4], vbh[4];
#define V_READ(L, H, e) do { _Pragma("unroll") for (int ks = 0; ks < 4; ++ks) { L[ks] = vtr(vp + (e) * 4096 + (ks >> 1) * 2048 + (ks & 1) * 512); H[ks] = vtr(vp + (e) * 4096 + (ks >> 1) * 2048 + (ks & 1) * 512 + 256); } } while (0)
#define V_FRAG(L, H, ks) (bf16x8){L[ks][0], L[ks][1], L[ks][2], L[ks][3], H[ks][0], H[ks][1], H[ks][2], H[ks][3]}
#define PV_MMA(L, H, e) do { o[e] = __builtin_amdgcn_mfma_f32_32x32x16_bf16(__builtin_bit_cast(bf16x8, pw0), V_FRAG(L, H, 0), o[e], 0, 0, 0); o[e] = __builtin_amdgcn_mfma_f32_32x32x16_bf16(__builtin_bit_cast(bf16x8, pw1), V_FRAG(L, H, 1), o[e], 0, 0, 0); \
                o[e] = __builtin_amdgcn_mfma_f32_32x32x16_bf16(__builtin_bit_cast(bf16x8, pw2), V_FRAG(L, H, 2), o[e], 0, 0, 0); o[e] = __builtin_amdgcn_mfma_f32_32x32x16_bf16(__builtin_bit_cast(bf16x8, pw3), V_FRAG(L, H, 3), o[e], 0, 0, 0); } while (0)
            V_READ(val, vah, 0); __builtin_amdgcn_sched_barrier(0);
            V_READ(vbl, vbh, 1); __builtin_amdgcn_sched_barrier(0);
            PV_MMA(val, vah, 0); __builtin_amdgcn_sched_barrier(0);
            V_READ(val, vah, 2); __builtin_amdgcn_sched_barrier(0);
            PV_MMA(vbl, vbh, 1); __builtin_amdgcn_sched_barrier(0);
            V_READ(vbl, vbh, 3); __builtin_amdgcn_sched_barrier(0);
            if (doqk) { QK_LOAD(slot1); } __builtin_amdgcn_sched_barrier(0);
            PV_MMA(val, vah, 2); __builtin_amdgcn_sched_barrier(0);
            PV_MMA(vbl, vbh, 3); __builtin_amdgcn_sched_barrier(0);
            if (doqk) { QK_CINIT(j + 1); asm volatile("s_waitcnt lgkmcnt(0)" ::: "memory"); __builtin_amdgcn_sched_barrier(0); QK_MMA(); }
#undef V_READ
#undef V_FRAG
#undef PV_MMA
        }
        if (m == 1 && j + 2 < nt) { if (j + 3 < nt) asm volatile("s_waitcnt vmcnt(4)" ::: "memory"); else asm volatile("s_waitcnt vmcnt(0)" ::: "memory"); }
        asm volatile("s_waitcnt lgkmcnt(0)\n\ts_barrier" ::: "memory");
        slot = slot1; slot1 = (slot1 + 1) & 3; slot3 = (slot3 + 1) & 3;
    }
    if (m == 0) asm volatile("s_barrier" ::: "memory");
#undef DIFF_QK
#undef QK_LOAD
#undef QK_CINIT
#undef QK_MMA
    l_reg += partner(l_reg, hi);
    { const float rl = (m == 1 ? lam : 1.f) / l_reg; if (hi == 0) wsf[32 + r32] = rl; }
    asm volatile("s_waitcnt lgkmcnt(0)" ::: "memory");
    float rli[16];
#pragma unroll
    for (int r = 0; r < 16; ++r) rli[r] = wsf[32 + crow(r, hi)];
    ATT_WAIT_BAR(0);
    LAS float* S = (LAS float*)(shm + rg * 16384);
    if (m == 1) {
#pragma unroll
        for (int e = 0; e < 4; ++e)
#pragma unroll
            for (int r = 0; r < 16; ++r) S[crow(r, hi) * 128 + e * 32 + r32] = o[e][r] * rli[r];
    }
    ATT_WAIT_BAR(0);
    if (m == 0) {
#pragma unroll
        for (int e = 0; e < 4; ++e)
#pragma unroll
            for (int r = 0; r < 16; ++r) { const int ix = crow(r, hi) * 128 + e * 32 + r32; S[ix] = o[e][r] * rli[r] - S[ix]; }
    }
    ATT_WAIT_BAR(0);
    { const int row = 16 * m + (lane >> 2), qq = lane & 3;
      const LAS f32x4* sp = (const LAS f32x4*)(S + row * 128 + qq * 32);
      f32x4 v[8]; float ss = 0.f;
#pragma unroll
      for (int i = 0; i < 8; ++i) { v[i] = sp[i]; ss += (v[i].x * v[i].x + v[i].y * v[i].y) + (v[i].z * v[i].z + v[i].w * v[i].w); }
      ss += swz_xor<1>(ss); ss += swz_xor<2>(ss);
      const float rn = 0.8f / sqrtf(ss * (1.f / 128.f) + 1e-5f);
      bf16* op = O + (rowbase + q0 + 32 * rg + row) * D + h * 128 + qq * 32;
#pragma unroll
      for (int i = 0; i < 4; ++i) { const f32x4 g0 = *(const f32x4*)(subg + qq * 32 + 8 * i), g1 = *(const f32x4*)(subg + qq * 32 + 8 * i + 4); const f32x4 a = v[2 * i] * rn * g0, c = v[2 * i + 1] * rn * g1;
          *(u32x4*)(op + 8 * i) = (u32x4){cvtpk_s(a.x, a.y), cvtpk_s(a.z, a.w), cvtpk_s(c.x, c.y), cvtpk_s(c.z, c.w)}; } }
    ATT_WAIT_BAR(0);
#undef DIFF_DMA
}

__device__ __forceinline__ void sb_unit(int b, int h, int qb, const bf16* Q, const bf16* K, const bf16* V, bf16* O, LAS unsigned char* shm, int tid) {
    const int lane = tid & 63, r32 = lane & 31, hi = lane >> 5; const int wid = __builtin_amdgcn_readfirstlane(tid >> 6);
    const long rowbase = (long)b * SEQ; const int q0 = qb * 256;
    const unsigned lds0 = (unsigned)(uintptr_t)shm;
    volatile LAS unsigned* flags = (volatile LAS unsigned*)(shm + 65536);
    const bf16* ksrc; { const int ri = lane >> 3, cp = lane & 7; const int key = 32 * (wid >> 2) + 16 * ((ri >> 2) & 1) + (ri & 3) + 4 * (wid & 3); const int c = cp ^ ((ri >> 1) & 3) ^ (((wid >> 1) & 1) << 2);
        ksrc = K + (rowbase + key) * D + h * 64 + c * 8; }
    const bf16* vsrc = V + (rowbase + 16 * (wid & 3) + (lane >> 2)) * D + h * 64 + (wid >> 2) * 32 + (lane & 3) * 8;
    const unsigned kdst = lds0 + wid * 1024, vdst = lds0 + 8192 + wid * 1024;
#define SB_DMA(j, slot) do { glds16(ksrc + (long)(j) * 64 * D, (unsigned)__builtin_amdgcn_readfirstlane(kdst + (slot) * 16384)); glds16(vsrc + (long)(j) * 64 * D, (unsigned)__builtin_amdgcn_readfirstlane(vdst + (slot) * 16384)); } while (0)
    const int jmax = 4 * qb + 3, jw = 4 * qb + (wid >> 1);
    SB_DMA(jmax, 0);
    if (lane == 0) flags[wid] = 0u;
    bf16x8 qr[4];
    { const bf16* Qw = Q + (rowbase + q0 + 32 * wid) * D + h * 64;
#pragma unroll
      for (int d0 = 0; d0 < 4; ++d0) qr[d0] = *reinterpret_cast<const bf16x8*>(&Qw[(long)r32 * D + d0 * 16 + hi * 8]); }
    float R = 1.f; f32x16 o[2]; o[0] = f32x16{}; o[1] = f32x16{};
    const int tloc0 = 32 * (wid & 1) + r32 - 16 * hi;
    const lds_cptr kp0 = (lds_cptr)shm + (r32 >> 3) * 1024 + (r32 & 7) * 128;
    int koff[4];
    { const int fz = ((r32 >> 1) & 3) | (((r32 >> 4) & 1) << 2);
#pragma unroll
      for (int d0 = 0; d0 < 4; ++d0) koff[d0] = ((2 * d0 + hi) ^ fz) * 16; }
    const lds_cptr vp0 = (lds_cptr)shm + 8192 + hi * 1024 + ((lane & 15) >> 2) * 64 + ((lane >> 4) & 1) * 32 + (lane & 3) * 8;
    bool mydone = false;
    for (int it = 0; it <= jmax; ++it) {
        const int j = jmax - it, slot = it & 1;
        ATT_WAIT_BAR(0);
        { unsigned all = 1u;
#pragma unroll
          for (int w = 0; w < NWAVES; ++w) all &= flags[w];
          if (all) break; }
        if (j > 0) SB_DMA(j - 1, slot ^ 1);
        if (j <= jw && !mydone) {
            f32x16 p0 = f32x16{}, p1 = f32x16{};
            const lds_cptr kp = kp0 + slot * 16384;
            bf16x8 kf[8];
#pragma unroll
            for (int d0 = 0; d0 < 4; ++d0) { kf[2 * d0] = *(const LAS bf16x8*)(kp + koff[d0]); kf[2 * d0 + 1] = *(const LAS bf16x8*)(kp + 4096 + koff[d0]); }
            asm volatile("s_waitcnt lgkmcnt(0)" ::: "memory"); __builtin_amdgcn_sched_barrier(0);
#pragma unroll
            for (int d0 = 0; d0 < 4; ++d0) { p0 = __builtin_amdgcn_mfma_f32_32x32x16_bf16(kf[2 * d0], qr[d0], p0, 0, 0, 0); p1 = __builtin_amdgcn_mfma_f32_32x32x16_bf16(kf[2 * d0 + 1], qr[d0], p1, 0, 0, 0); }
            if (j == jw) {
#pragma unroll
                for (int r = 0; r < 16; ++r) { if (r >= tloc0) p0[r] = -INFINITY; if (r + 32 >= tloc0) p1[r] = -INFINITY; }
            }
            float TA = 1.f, TB = 1.f;
#pragma unroll
            for (int r = 0; r < 16; ++r) { p0[r] = __builtin_amdgcn_rcpf(1.f + __builtin_amdgcn_exp2f(p0[r])); p1[r] = __builtin_amdgcn_rcpf(1.f + __builtin_amdgcn_exp2f(p1[r])); TA *= p0[r]; TB *= p1[r]; }
            const float TAp = partner(TA, hi), TBp = partner(TB, hi);
            const float preB = hi ? R : R * TBp;
            const float preA = hi ? (R * TB) * TBp : ((R * TBp) * TB) * TAp;
            R = (((R * TA) * TB) * TAp) * TBp;
            { float e = preB;
#pragma unroll
              for (int r = 15; r >= 0; --r) { const float f = p1[r]; p1[r] = (1.f - f) * e; e *= f; }
              e = preA;
#pragma unroll
              for (int r = 15; r >= 0; --r) { const float f = p0[r]; p0[r] = (1.f - f) * e; e *= f; } }
            const u32x4 pw0 = ATT_PACK(p0, 0), pw1 = ATT_PACK(p0, 8), pw2 = ATT_PACK(p1, 0), pw3 = ATT_PACK(p1, 8);
            const lds_cptr vp = vp0 + slot * 16384;
#pragma unroll
            for (int e = 0; e < 2; ++e) {
                s16x4 vl[4], vh[4];
#pragma unroll
                for (int ks = 0; ks < 4; ++ks) { vl[ks] = vtr(vp + e * 4096 + (ks >> 1) * 2048 + (ks & 1) * 512); vh[ks] = vtr(vp + e * 4096 + (ks >> 1) * 2048 + (ks & 1) * 512 + 256); }
                asm volatile("s_waitcnt lgkmcnt(0)" ::: "memory"); __builtin_amdgcn_sched_barrier(0);
#define SB_PV(ks, PW) o[e] = __builtin_amdgcn_mfma_f32_32x32x16_bf16(__builtin_bit_cast(bf16x8, PW), (bf16x8){vl[ks][0], vl[ks][1], vl[ks][2], vl[ks][3], vh[ks][0], vh[ks][1], vh[ks][2], vh[ks][3]}, o[e], 0, 0, 0)
                SB_PV(0, pw0); SB_PV(1, pw1); SB_PV(2, pw2); SB_PV(3, pw3);
#undef SB_PV
            }
            mydone = __all(R < 1e-30f);
            if (mydone && lane == 0) flags[wid] = 1u;
        }
    }
    ATT_WAIT_BAR(0);
    { bf16* Ow = O + (rowbase + q0 + 32 * wid) * D + h * 64;
      LAS bf16* stg = (LAS bf16*)(shm + 32768 + wid * 4096);
#pragma unroll
      for (int r = 0; r < 16; ++r) { const int orow = crow(r, hi);
#pragma unroll
          for (int e = 0; e < 2; ++e) stg[orow * 64 + e * 32 + r32] = (bf16)(cvtpk_s(o[e][r], 0.f) & 0xffffu); }
      asm volatile("s_waitcnt lgkmcnt(0)" ::: "memory");
#pragma unroll
      for (int i = 0; i < 4; ++i) { const int row = i * 8 + (lane >> 3), ch = lane & 7; const u32x4 v = *(const LAS u32x4*)(stg + row * 64 + ch * 8); *(u32x4*)(Ow + (long)row * D + ch * 8) = v; } }
    ATT_WAIT_BAR(0);
#undef SB_DMA
}
}

struct Args {
    const float* in[23]; float* out; unsigned char* ws; int ph_lo, ph_hi;
};

__global__ void __launch_bounds__(NTHR, 2) fwd(Args args) {
    extern __shared__ __attribute__((aligned(16))) unsigned char lds_raw[];
    LAS unsigned char* lds = (LAS unsigned char*)lds_raw;
    volatile LAS unsigned* MISC = (volatile LAS unsigned*)(lds + MISC_OFF);
    const int G = gridDim.x, bx = blockIdx.x;
    const int wave0 = __builtin_amdgcn_readfirstlane(threadIdx.x >> 6);
#define PHASE_IDS() int lane_; asm volatile("v_mbcnt_lo_u32_b32 %0, -1, 0\n\tv_mbcnt_hi_u32_b32 %0, -1, %0" : "=v"(lane_) : "s"(ph_tag) : "memory"); const int lane = lane_, wave = wave0, tid = wave0 * 64 + lane_; const int gw = vcu * NWAVES + wave; (void)lane; (void)gw; (void)tid
    const int vcu = (G % 8 == 0) ? (bx % 8) * (G / 8) + bx / 8 : bx;
    unsigned char* ws = args.ws;
    gu32* ctl = (gu32*)(ws + WS_CTL);
    for (int u = threadIdx.x; u < (LDS_BYTES - MISC_OFF) / 4; u += NTHR) ((LAS unsigned*)(lds + MISC_OFF))[u] = 0u;
    __syncthreads();
    XcdBarrier bar; bar.bar = (unsigned*)ctl + CW_BAR; bar.x = 0; bar.st = nullptr;
    if (MK_ONE_LAUNCH) bar = xcd_barrier_post((unsigned*)ctl + CW_BAR, MISC + 8);
#define GRID_BAR() do { if (MK_ONE_LAUNCH) xcd_barrier(bar); } while (0)
    const int lo = args.ph_lo, hi = args.ph_hi;
    int ph_tag = lo;
#define IN(k) (lo <= (k) && (k) < hi)
#define BOTH(k) (IN(k) && IN((k) + 1))
    const float* x_in = args.in[0]; const float* c_in = args.in[1];
    const float* norm1_g = args.in[2]; const float* norm2_g = args.in[3];
    const float* ada_w = args.in[4]; const float* ada_b = args.in[5];
    float* out_f32 = args.out; bf16* XS = (bf16*)(ws + WS_XS);
    float* mod = (float*)(ws + WS_MOD);
    bf16* XN = (bf16*)(ws + WS_XN); bf16* Qb = (bf16*)(ws + WS_Q); bf16* Kb = (bf16*)(ws + WS_K); bf16* Vb = (bf16*)(ws + WS_V); bf16* Ob = (bf16*)(ws + WS_O);
    bf16* Hm = (bf16*)(ws + WS_HM); bf16* Yd = (bf16*)(ws + WS_YD);
    const int NGW = G * NWAVES;

    if (IN(0)) {
            PHASE_IDS();
        if (bx < 192) {
            LAS float* cond = (LAS float*)lds; LAS float* red = (LAS float*)(lds + 32768);
            const int l = bx / 96, j0 = (bx % 96) * 64;
            for (int i = tid; i < BATCH * D; i += NTHR) { const float v = c_in[i]; cond[i] = v / (1.f + __expf(-v)); }
            __syncthreads();
            float acc[BATCH];
#pragma unroll
            for (int b = 0; b < BATCH; ++b) acc[b] = 0.f;
            const float* W = ada_w + (size_t)l * D * 6 * D + j0 + lane;
#pragma unroll 8
            for (int k = wave * 128; k < wave * 128 + 128; ++k) {
                const float w = W[(size_t)k * 6 * D];
#pragma unroll
                for (int b = 0; b < BATCH; ++b) acc[b] += cond[b * D + k] * w;
            }
#pragma unroll
            for (int b = 0; b < BATCH; ++b) red[(wave * BATCH + b) * 64 + lane] = acc[b];
            __syncthreads();
            { const int b = tid >> 6, j = tid & 63; float s = ada_b[(size_t)l * 6 * D + j0 + j];
#pragma unroll
              for (int w = 0; w < NWAVES; ++w) s += red[(w * BATCH + b) * 64 + j];
              mod[((size_t)l * BATCH + b) * 6 * D + j0 + j] = s; }
        }
        if (BOTH(0)) GRID_BAR();
#ifdef XBAR
        for (int xb_ = 0; xb_ < XBAR; ++xb_) GRID_BAR();
#endif
    }

    if (IN(1)) {
            PHASE_IDS();
for (int rep_ = 0; rep_ < NREP(0, true); ++rep_) {
        LAS float* scr = (LAS float*)(lds + wave * 16384);
        constexpr int I_IN = 16 * 96, I_OUT = 16 * 32, I_G = 32 * 256, I_D = 32 * 256, I_LAYER = I_IN + I_OUT + 2 * I_G + I_D;
#define CONV_DECODE(c, it_) do { const int l_ = (it_) / I_LAYER; int r_ = (it_) % I_LAYER; unsigned char* wl_ = ws + WS_W + (size_t)l_ * W_LAYER; \
            if (r_ < I_IN) { c.W = args.in[l_ == 0 ? 6 : 13]; c.K = D; c.N = 3 * D; c.WT = (bf16*)(wl_ + W_IN); c.n0 = 32 * (r_ % 96); c.k0 = 64 * (r_ / 96); c.drow = c.n0; } \
            else if (r_ < I_IN + I_OUT) { r_ -= I_IN; c.W = args.in[l_ == 0 ? 7 : 14]; c.K = D; c.N = D; c.WT = (bf16*)(wl_ + W_OUT); c.n0 = 32 * (r_ % 32); c.k0 = 64 * (r_ / 32); c.drow = c.n0; } \
            else if (r_ < I_IN + I_OUT + 2 * I_G) { r_ -= I_IN + I_OUT; const int up_ = r_ / I_G; r_ %= I_G; const int e_ = r_ / 256, rr_ = r_ % 256; \
                c.W = args.in[up_ ? 20 : 19] + ((size_t)l_ * NE + e_) * D * FH; c.K = D; c.N = FH; c.WT = (bf16*)(wl_ + W_GU) + (size_t)e_ * D * D; c.n0 = 32 * (rr_ % 16); c.k0 = 64 * (rr_ / 16); c.drow = (c.n0 / 128) * 256 + (c.n0 % 128) + up_ * 128; } \
            else { r_ -= I_IN + I_OUT + 2 * I_G; const int e_ = r_ / 256, rr_ = r_ % 256; \
                c.W = args.in[21] + ((size_t)l_ * NE + e_) * FH * D; c.K = FH; c.N = D; c.WT = (bf16*)(wl_ + W_DN) + (size_t)e_ * D * FH; c.n0 = 32 * (rr_ % 32); c.k0 = 64 * (rr_ / 32); c.drow = c.n0; } } while (0)
        {
            constexpr int NIT = DEPTH * I_LAYER;
            ConvItem ca, cb; f32x4 ta[8], tb[8];
            int it = gw;
            if (it < NIT) { CONV_DECODE(ca, it); conv_issue(ta, ca, lane); }
            while (it < NIT) {
                if (it + NGW < NIT) { CONV_DECODE(cb, it + NGW); conv_issue(tb, cb, lane); }
                conv_finish(ta, ca, scr, lane);
                it += NGW; if (it >= NIT) break;
                if (it + NGW < NIT) { CONV_DECODE(ca, it + NGW); conv_issue(ta, ca, lane); }
                conv_finish(tb, cb, scr, lane);
                it += NGW;
            }
        }
#undef CONV_DECODE
        { float* rt = (float*)(ws + WS_RT);
          for (int i = gw * 64 + lane; i < DEPTH * 36 * D; i += NGW * 64) { const int l = i / (36 * D), j = (i / D) % 36, k = i % D;
              rt[i] = (j < 4) ? args.in[15][((size_t)l * D + k) * NG + j] : args.in[17][((size_t)l * D + k) * NE + (j - 4)]; } }
        for (int m0 = gw * 4; m0 < NTOK; m0 += NGW * 4) {
            const float* mb = mod + (size_t)(m0 / SEQ) * 6 * D;
            f32x4 g[4], s1[4], s0[4]; load_mod(g, s1, s0, norm1_g, mb, mb + D, lane);
            f32x4 v[4][4];
#pragma unroll
            for (int i = 0; i < 4; ++i)
#pragma unroll
                for (int j = 0; j < 4; ++j) v[i][j] = ((const GAS f32x4*)(x_in + (size_t)(m0 + i) * D) + lane)[64 * j];
#pragma unroll
            for (int i = 0; i < 4; ++i) { norm_apply(v[i], g, s1, s0, 1e-6f); store_row_bf16(XN + (size_t)(m0 + i) * D, v[i], lane); }
        }
}
                    if (BOTH(1)) GRID_BAR();
    }

#pragma unroll 1
    for (int l = 0; l < DEPTH; ++l) {
        const int pb = 2 + 8 * l; ph_tag = pb;
        unsigned char* wl = ws + WS_W + (size_t)l * W_LAYER;
        const float* modl = mod + (size_t)l * BATCH * 6 * D;
        int* eid = (int*)(ws + WS_EID + l * LSTRIDE); float* ew = (float*)(ws + WS_EW + l * LSTRIDE); int* hist = (int*)(ws + WS_HIST + l * LSTRIDE);
        int* sop = (int*)(ws + WS_SOP + l * LSTRIDE); int* stok = (int*)(ws + WS_STOK + l * LSTRIDE); int* tiles = (int*)(ws + WS_TILES + l * LSTRIDE);

        if (IN(pb + 0)) {
            PHASE_IDS();
for (int rep_ = 0; rep_ < NREP(1, true); ++rep_) {
            pg8::StaticOrder S; S.init(NTOK, 3 * D, G, bx, (const bf16*)(wl + W_IN));
            pg8::EpiBf16 E{Qb, D, D, (size_t)(WS_K - WS_Q) / 2, C2};
            pg8::gemm_phase<pg8::EpiBf16, pg8::StaticOrder, false>(lds, XN, D, nullptr, S, E, tid);
}
                        if (BOTH(pb + 0)) GRID_BAR();
        }
        if (IN(pb + 1)) {
            PHASE_IDS();
for (int rep_ = 0; rep_ < ((NREP(2, l == 0) > 1 || NREP(3, l == 1) > 1) ? 2 : 1); ++rep_) {
            if (l == 0) {
                const float* lq1 = args.in[8]; const float* lk1 = args.in[9]; const float* lq2 = args.in[10]; const float* lk2 = args.in[11];
                const float lam = __expf(wave_sum(lq1[lane] * lk1[lane])) - __expf(wave_sum(lq2[lane] * lk2[lane])) + 0.2f;
                const int bh = vcu >> 2, s4 = vcu & 3;
                for (int i = 0; i < 4; ++i) { const int qb = (i == 0) ? s4 : (i == 1) ? 7 - s4 : (i == 2) ? 8 + s4 : 15 - s4;
                    att::diff_unit<0>(bh >> 3, bh & 7, qb, Qb, Kb, Vb, Ob, lds, lam, args.in[12], tid); }
#ifdef DIFF_PROBE
                for (int i = 0; i < 4; ++i) { const int qb = (i == 0) ? s4 : (i == 1) ? 7 - s4 : (i == 2) ? 8 + s4 : 15 - s4;
                    att::diff_unit<DIFF_PROBE>(bh >> 3, bh & 7, qb, Qb, Kb, Vb, (bf16*)(ws + WS_END), lds, lam, args.in[12], tid); }
#endif
            } else {
                const int bh = vcu >> 1, hf = vcu & 1;
                for (int i = 0; i < 4; ++i) { const int qb = (i == 0) ? 2 * hf : (i == 1) ? 7 - 2 * hf : (i == 2) ? 2 * hf + 1 : 6 - 2 * hf;
                    att::sb_unit(bh >> 4, bh & 15, qb, Qb, Kb, Vb, Ob, lds, tid); }
            }
}
                        if (BOTH(pb + 1)) GRID_BAR();
        }
        if (IN(pb + 2)) {
            PHASE_IDS();
for (int rep_ = 0; rep_ < NREP(4, l == 0); ++rep_) {
            pg8::StaticOrder S; S.init(NTOK, D, G, bx, (const bf16*)(wl + W_OUT));
            pg8::EpiResid E{XS, l == 0 ? x_in : nullptr, XS, D, modl + 2 * D, 6 * D, SEQ};
            pg8::gemm_phase<pg8::EpiResid, pg8::StaticOrder, false>(lds, Ob, D, nullptr, S, E, tid);
}
                        if (BOTH(pb + 2)) GRID_BAR();
        }
        if (IN(pb + 3)) {
            PHASE_IDS();
for (int rep_ = 0; rep_ < NREP(5, true); ++rep_) {
            LAS float* wl_ = (LAS float*)lds;
            LAS int* lhist = (LAS int*)(lds + MISC_OFF + 256);
            const float* rgb = args.in[16] + l * NG; const float* reb = args.in[18] + l * NE;
            { const GAS f32x4* rt4 = (const GAS f32x4*)(ws + WS_RT + (size_t)l * 36 * D * 4);
              for (int i = tid; i < 36 * D / 4; i += NTHR) ((LAS f32x4*)wl_)[i] = rt4[i]; }
            if (tid < NE) lhist[tid] = 0;
            __syncthreads();
            {
                const int tok0 = bx * 64 + wave * 8;
                const float* mb = modl + (size_t)(tok0 / SEQ) * 6 * D;
                f32x4 g[4], s1[4], s0[4]; load_mod(g, s1, s0, norm2_g + l * D, mb + 3 * D, mb + 4 * D, lane);
                f32x4 va[4][4];
#define LOAD4(v, T0) do { _Pragma("unroll") for (int i = 0; i < 4; ++i) _Pragma("unroll") for (int j = 0; j < 4; ++j) { const v2u q_ = ((const GAS v2u*)(XS + (size_t)((T0) + i) * D) + lane)[64 * j]; v[i][j] = (f32x4){bf_lo(q_.x), bf_hi(q_.x), bf_lo(q_.y), bf_hi(q_.y)}; } } while (0)
                LOAD4(va, tok0);
#define ROUTE4(v, T0) do { \
                _Pragma("unroll") for (int i = 0; i < 4; ++i) { norm_apply(v[i], g, s1, s0, 1e-6f); store_row_bf16(XN + (size_t)((T0) + i) * D, v[i], lane); } \
                float gl[4][4]; \
                _Pragma("unroll") for (int gq = 0; gq < 4; ++gq) { f32x4 w[4]; _Pragma("unroll") for (int j = 0; j < 4; ++j) w[j] = *(const LAS f32x4*)(wl_ + gq * D + 4 * lane + 256 * j); \
                    _Pragma("unroll") for (int i = 0; i < 4; ++i) { float sx = 0.f; _Pragma("unroll") for (int j = 0; j < 4; ++j) sx += (v[i][j].x * w[j].x + v[i][j].y * w[j].y) + (v[i][j].z * w[j].z + v[i][j].w * w[j].w); gl[i][gq] = sx; } } \
                _Pragma("unroll") for (int i = 0; i < 4; ++i) _Pragma("unroll") for (int gq = 0; gq < 4; ++gq) gl[i][gq] = wave_sum(gl[i][gq]) + rgb[gq]; \
                int gi[4]; float gwt[4]; \
                _Pragma("unroll") for (int i = 0; i < 4; ++i) { int gx = 0; float gm = gl[i][0]; _Pragma("unroll") for (int gq = 1; gq < 4; ++gq) if (gl[i][gq] > gm) { gm = gl[i][gq]; gx = gq; } \
                    float gs = 0.f; _Pragma("unroll") for (int gq = 0; gq < 4; ++gq) gs += __expf(gl[i][gq] - gm); gwt[i] = 1.0f / gs; gi[i] = __builtin_amdgcn_readfirstlane(gx); } \
                float ev[4][8]; \
                _Pragma("unroll") for (int i = 0; i < 4; ++i) _Pragma("unroll") for (int jx = 0; jx < 8; ++jx) { const LAS float* wr_ = wl_ + (4 + gi[i] * 8 + jx) * D; float sx = 0.f; \
                    _Pragma("unroll") for (int j = 0; j < 4; ++j) { const f32x4 w = *(const LAS f32x4*)(wr_ + 4 * lane + 256 * j); sx += (v[i][j].x * w.x + v[i][j].y * w.y) + (v[i][j].z * w.z + v[i][j].w * w.w); } ev[i][jx] = sx; } \
                _Pragma("unroll") for (int i = 0; i < 4; ++i) _Pragma("unroll") for (int jx = 0; jx < 8; ++jx) ev[i][jx] = wave_sum(ev[i][jx]); \
                _Pragma("unroll") for (int i = 0; i < 4; ++i) { float v1 = -INFINITY, v2 = -INFINITY; int i1 = 0, i2 = 0; \
                    _Pragma("unroll") for (int jx = 0; jx < 8; ++jx) { const float e_ = ev[i][jx] + reb[gi[i] * 8 + jx]; if (e_ > v1) { v2 = v1; i2 = i1; v1 = e_; i1 = jx; } else if (e_ > v2) { v2 = e_; i2 = jx; } } \
                    if (lane == 0) { const int tok = (T0) + i; const float e2 = __expf(v2 - v1), den = 1.f / (1.f + e2); \
                        eid[tok * 2] = gi[i] * 8 + i1; eid[tok * 2 + 1] = gi[i] * 8 + i2; ew[tok * 2] = gwt[i] * den; ew[tok * 2 + 1] = gwt[i] * e2 * den; \
                        atomicAdd((int*)(lhist + gi[i] * 8 + i1), 1); atomicAdd((int*)(lhist + gi[i] * 8 + i2), 1); } } } while (0)
                ROUTE4(va, tok0); LOAD4(va, tok0 + 4); ROUTE4(va, tok0 + 4);
#undef ROUTE4
#undef LOAD4
            }
            __syncthreads();
            if (tid < NE) hist[bx * NE + tid] = lhist[tid];
}
                        if (BOTH(pb + 3)) GRID_BAR();
        }
        if (IN(pb + 4)) {
            PHASE_IDS();
            LAS int* tot = (LAS int*)lds; LAS int* bef = tot + 16 * NE; LAS int* pst = bef + 16 * NE; LAS int* tote = pst + 64; LAS int* befe = tote + 32; LAS int* le = befe + 32;
            { const int e = tid & 31, part = tid >> 5; int s = 0, sb = 0;
              for (int w = part * 16; w < part * 16 + 16; ++w) { const int hv = hist[w * NE + e]; s += hv; if (w < bx) sb += hv; }
              tot[part * NE + e] = s; bef[part * NE + e] = sb; }
            __syncthreads();
            if (tid < NE) { int s = 0, sb = 0; for (int p = 0; p < 16; ++p) { s += tot[p * NE + tid]; sb += bef[p * NE + tid]; } tote[tid] = s; befe[tid] = sb; }
            __syncthreads();
            if (tid == 0) { int off = 0; for (int e = 0; e < NE; ++e) { pst[e] = off; off += (tote[e] + 255) / 256 * 256; } pst[NE] = off; }
            if (tid < 128) le[tid] = eid[(bx * 64) * 2 + tid];
            __syncthreads();
            if (tid < 128) { const int e = le[tid]; int rank = 0; for (int q = 0; q < tid; ++q) rank += (le[q] == e) ? 1 : 0;
                const int s = pst[e] + befe[e] + rank; stok[s] = bx * 64 + (tid >> 1); sop[(bx * 64) * 2 + tid] = s; }
            if (bx < NE) { const int e = bx; for (int s = pst[e] + tote[e] + tid; s < pst[e + 1]; s += NTHR) stok[s] = 0; }
            if (bx == NE) { if (tid < NE) { for (int t = pst[tid] / 256; t < pst[tid + 1] / 256; ++t) tiles[1 + t] = tid; } if (tid == 0) tiles[0] = pst[NE] / 256; }
            if (BOTH(pb + 4)) GRID_BAR();
        }
        if (IN(pb + 5)) {
            PHASE_IDS();
for (int rep_ = 0; rep_ < NREP(6, true); ++rep_) {
            LAS int* tl = (LAS int*)(lds + AUX_OFF); LAS int* gidx = tl + 256;
            if (tid < 1 + MAX_TILES) tl[tid] = tiles[tid + vzero()];
            __syncthreads();
            pg8::GroupedOrder S{tl, G, vcu, (const bf16*)(wl + W_GU), (size_t)D * D};
            { pg8::Unit u; for (int i = 0; i < 3 && S.next(i, u); ++i) { if (tid < 256) gidx[i * 256 + tid] = stok[u.pm * 256 + tid]; } }
            __syncthreads();
            pg8::EpiSwiGLU E{Hm, FH};
            pg8::gemm_phase<pg8::EpiSwiGLU, pg8::GroupedOrder, true>(lds, XN, D, gidx, S, E, tid);
}
                        if (BOTH(pb + 5)) GRID_BAR();
        }
        if (IN(pb + 6)) {
            PHASE_IDS();
for (int rep_ = 0; rep_ < NREP(7, true); ++rep_) {
            LAS int* tl = (LAS int*)(lds + AUX_OFF);
            if (tid < 1 + MAX_TILES) tl[tid] = tiles[tid + vzero()];
            __syncthreads();
            pg8::GroupedOrder S{tl, G, vcu, (const bf16*)(wl + W_DN), (size_t)D * FH};
            pg8::EpiBf16 E{Yd, D, 0, 0, 1.f};
            pg8::gemm_phase<pg8::EpiBf16, pg8::GroupedOrder, false>(lds, Hm, FH, nullptr, S, E, tid);
}
                        if (BOTH(pb + 6)) GRID_BAR();
        }
        if (IN(pb + 7)) {
            PHASE_IDS();
            for (int m0 = gw * 8; m0 < NTOK; m0 += NGW * 8) {
                const int b = m0 / SEQ; const float* mb = modl + (size_t)b * 6 * D;
                const int sv = sop[m0 * 2 + (lane & 15)]; const float wv = ew[m0 * 2 + (lane & 15)];
                f32x4 g2[4];
#pragma unroll
                for (int j = 0; j < 4; ++j) g2[j] = *(const f32x4*)(mb + 5 * D + 4 * lane + 256 * j);
#pragma unroll 1
                for (int hb = 0; hb < 2; ++hb) {
                    f32x4 v[4][4]; v2u ya[4][4], yc[4][4]; float w0[4], w1[4];
#pragma unroll
                    for (int i = 0; i < 4; ++i) { const int r = hb * 4 + i; const int sa = __builtin_amdgcn_readlane(sv, 2 * r), sc_ = __builtin_amdgcn_readlane(sv, 2 * r + 1); w0[i] = __builtin_bit_cast(float, __builtin_amdgcn_readlane(__builtin_bit_cast(int, wv), 2 * r)); w1[i] = __builtin_bit_cast(float, __builtin_amdgcn_readlane(__builtin_bit_cast(int, wv), 2 * r + 1));
#pragma unroll
                        for (int j = 0; j < 4; ++j) { { const v2u q_ = ((const GAS v2u*)(XS + (size_t)(m0 + r) * D) + lane)[64 * j]; v[i][j] = (f32x4){bf_lo(q_.x), bf_hi(q_.x), bf_lo(q_.y), bf_hi(q_.y)}; }
                            ya[i][j] = ((const GAS v2u*)(Yd + (size_t)sa * D) + lane)[64 * j]; yc[i][j] = ((const GAS v2u*)(Yd + (size_t)sc_ * D) + lane)[64 * j]; } }
#pragma unroll
                    for (int i = 0; i < 4; ++i) {
#pragma unroll
                        for (int j = 0; j < 4; ++j) { const v2u a = ya[i][j], c = yc[i][j];
                            f32x4 y; y.x = w0[i] * bf_lo(a.x) + w1[i] * bf_lo(c.x); y.y = w0[i] * bf_hi(a.x) + w1[i] * bf_hi(c.x); y.z = w0[i] * bf_lo(a.y) + w1[i] * bf_lo(c.y); y.w = w0[i] * bf_hi(a.y) + w1[i] * bf_hi(c.y);
                            v[i][j] = v[i][j] + g2[j] * y; } }
                    asm volatile("" ::: "memory");
                    f32x4 g[4], s1[4], s0[4];
                    if (l + 1 < DEPTH) { const float* mn = mod + ((size_t)(l + 1) * BATCH + b) * 6 * D; load_mod(g, s1, s0, norm1_g + (l + 1) * D, mn, mn + D, lane); }
                    else load_mod(g, s1, s0, args.in[22], nullptr, nullptr, lane);
#pragma unroll
                    for (int i = 0; i < 4; ++i) { const int r = hb * 4 + i; GAS f32x4* xr = (GAS f32x4*)(out_f32 + (size_t)(m0 + r) * D) + lane;
                        if (l + 1 < DEPTH) {
                            store_row_bf16(XS + (size_t)(m0 + r) * D, v[i], lane);
                            norm_apply(v[i], g, s1, s0, 1e-6f); store_row_bf16(XN + (size_t)(m0 + r) * D, v[i], lane);
                        } else { norm_apply(v[i], g, s1, s0, 1e-6f);
#pragma unroll
                            for (int j = 0; j < 4; ++j) xr[64 * j] = v[i][j]; } }
                }
            }
            if (BOTH(pb + 7)) GRID_BAR();
        }
    }
#undef IN
#undef BOTH
}

extern "C" void kernel_launch(void* const* d_in, const int* in_sizes, int n_in, void* d_out, int out_size, void* d_ws, size_t ws_size, hipStream_t stream) {
    static int grid = 0;
    if (grid == 0) {
        if (n_in != 23 || out_size != NTOK * D || ws_size < WS_END) { fprintf(stderr, "kernel_launch: unexpected shapes (n_in %d out %d ws %zu)\n", n_in, out_size, ws_size); grid = -1; return; }
        int dev = 0, cus = 0, per_cu = 0;
        if (hipGetDevice(&dev) != hipSuccess || hipDeviceGetAttribute(&cus, hipDeviceAttributeMultiprocessorCount, dev) != hipSuccess) { grid = -1; return; }
        if (hipFuncSetAttribute((const void*)fwd, hipFuncAttributeMaxDynamicSharedMemorySize, LDS_BYTES) != hipSuccess) { fprintf(stderr, "kernel_launch: hipFuncSetAttribute failed\n"); grid = -1; return; }
        if (hipOccupancyMaxActiveBlocksPerMultiprocessor(&per_cu, (const void*)fwd, NTHR, LDS_BYTES) != hipSuccess || per_cu < 1) fprintf(stderr, "kernel_launch: occupancy query reports %d\n", per_cu);
        (void)hipGetLastError();
        grid = cus;
        if (grid != 256) { fprintf(stderr, "kernel_launch: built for 256 CUs, found %d\n", cus); grid = -1; return; }
    }
    if (grid < 0) return;
    (void)in_sizes;
    if (hipMemsetAsync((char*)d_ws + WS_CTL, 0, CTL_ZERO_BYTES, stream) != hipSuccess) return;
    Args a{};
    for (int i = 0; i < 23; ++i) a.in[i] = (const float*)d_in[i];
    a.out = (float*)d_out; a.ws = (unsigned char*)d_ws;
#if MK_ONE_LAUNCH
    a.ph_lo = 0; a.ph_hi = NPHASE;
    hipLaunchKernelGGL(fwd, dim3(grid), dim3(NTHR), LDS_BYTES, stream, a);
#else
    for (int p = 0; p < NPHASE; ++p) { a.ph_lo = p; a.ph_hi = p + 1; hipLaunchKernelGGL(fwd, dim3(grid), dim3(NTHR), LDS_BYTES, stream, a); }
#endif
}
```
